# Optimizing an MI355X kernel written in HIP

```python
import jax, jax.numpy as jnp
from jax import lax
import numpy as np

D_MODEL = 1024
BATCH = 4
SEQ = 4096
DEPTH = 1

HEAD_DIM = 64
ATTN_Q_HEADS = D_MODEL // (2 * HEAD_DIM)
ATTN_KV_HEADS = ATTN_Q_HEADS // 4
ATTN_GROUP = ATTN_Q_HEADS // ATTN_KV_HEADS
ATTN_WIDTH = ATTN_Q_HEADS * HEAD_DIM
KV_WIDTH = ATTN_KV_HEADS * HEAD_DIM
WINDOW = 128
BLOCK = 128
ROPE_THETA = 500000.0
ROT_DIM = HEAD_DIM // 4
RWKV_HEADS = D_MODEL // (2 * HEAD_DIM)
RWKV_WIDTH = RWKV_HEADS * HEAD_DIM
DECAY_RANK = 64
ICLR_RANK = 64
GATE_RANK = 128
N_BRANCH = 2
D_FF = 4 * D_MODEL
PLE_DIM = 256
NORM_EPS = 1e-6
GN_EPS = 64e-5
O_Q = 0
O_K = O_Q + ATTN_WIDTH
O_V = O_K + KV_WIDTH
O_RWKV = O_V + KV_WIDTH
RWKV_COLS = 3 * RWKV_WIDTH + DECAY_RANK + ICLR_RANK + GATE_RANK
O_GATE = O_RWKV + RWKV_COLS
IN_COLS = O_GATE + N_BRANCH * D_MODEL

kernel_name = 'hybrid_swa_rwkv7_encoder'


def rms_norm(x, g):
    xf = x.astype(jnp.float32)
    y = xf * lax.rsqrt(jnp.mean(xf * xf, axis=-1, keepdims=True) + NORM_EPS)
    return (y * g.astype(jnp.float32)).astype(x.dtype)


def rotary_partial(x, positions):
    half = ROT_DIM // 2
    inv_freq = jnp.power(jnp.float32(ROPE_THETA), -jnp.arange(half, dtype=jnp.float32) * 2.0 / ROT_DIM)
    ang = positions.astype(jnp.float32)[:, None] * inv_freq[None, :]
    cos = jnp.cos(ang)[None, :, None, :]
    sin = jnp.sin(ang)[None, :, None, :]
    xf = x[..., :ROT_DIM].astype(jnp.float32)
    x1, x2 = xf[..., :half], xf[..., half:]
    rot = jnp.concatenate([x1 * cos - x2 * sin, x2 * cos + x1 * sin], axis=-1).astype(x.dtype)
    return jnp.concatenate([rot, x[..., ROT_DIM:]], axis=-1)


def band_windows(t, n_blocks):
    b, _, h, d = t.shape
    tp = jnp.pad(t, ((0, 0), (BLOCK, BLOCK), (0, 0), (0, 0))).reshape(b, n_blocks + 2, BLOCK, h, d)
    return jnp.concatenate([tp[:, :-2], tp[:, 1:-1], tp[:, 2:]], axis=2)


def windowed_gqa(q, k, v, sink):
    b, s = q.shape[0], q.shape[1]
    nb = s // BLOCK
    qb = q.reshape(b, nb, BLOCK, ATTN_KV_HEADS, ATTN_GROUP, HEAD_DIM)
    kw = band_windows(k, nb)
    vw = band_windows(v, nb)
    scores = jnp.einsum('bnqhgd,bnkhd->bnhgqk', qb, kw).astype(jnp.float32) * (HEAD_DIM ** -0.5)
    qpos = jnp.arange(nb)[:, None] * BLOCK + jnp.arange(BLOCK)[None, :]
    kpos = (jnp.arange(nb)[:, None] - 1) * BLOCK + jnp.arange(3 * BLOCK)[None, :]
    valid = ((jnp.abs(qpos[:, :, None] - kpos[:, None, :]) <= WINDOW)
             & (kpos[:, None, :] >= 0) & (kpos[:, None, :] < s))
    scores = jnp.where(valid[None, :, None, None], scores, -1e30)
    sink_logit = jnp.broadcast_to(
        sink.astype(jnp.float32).reshape(ATTN_KV_HEADS, ATTN_GROUP)[None, None, :, :, None, None],
        scores.shape[:-1] + (1,))
    probs = jax.nn.softmax(jnp.concatenate([scores, sink_logit], axis=-1), axis=-1)[..., :-1]
    out = jnp.einsum('bnhgqk,bnkhd->bnqhgd', probs.astype(v.dtype), vw)
    return out.reshape(b, s, ATTN_WIDTH)


def centred_shift(z):
    prev = jnp.pad(z[:, :-1], ((0, 0), (1, 0), (0, 0)))
    nxt = jnp.pad(z[:, 1:], ((0, 0), (0, 1), (0, 0)))
    return 0.5 * (prev + nxt)


def rwkv7_bidir_scan(r, w, k, v, a, b):
    xs = (jnp.moveaxis(r, 2, 0), jnp.moveaxis(w, 2, 0), jnp.moveaxis(k, 2, 0),
          jnp.moveaxis(v, 2, 0), jnp.moveaxis(a, 2, 0), jnp.moveaxis(b, 2, 0))

    def step(state, inp):
        r_t, w_t, k_t, v_t, a_t, b_t = inp
        sa = jnp.einsum('dbhij,dbhj->dbhi', state, a_t)
        state = (state * w_t[..., None, :] + sa[..., :, None] * b_t[..., None, :]
                 + v_t[..., :, None] * k_t[..., None, :])
        y = jnp.einsum('dbhij,dbhj->dbhi', state, r_t)
        return state, y

    d, bsz, _, h, n = r.shape
    s0 = jnp.zeros((d, bsz, h, n, n), jnp.float32)
    _, ys = lax.scan(step, s0, xs)
    return jnp.moveaxis(ys, 0, 2)


def rwkv7_time_mix(z, w0, w2, a0, a2, g2, k_k, k_a, r_k, lnx_w, lnx_b):
    f32 = jnp.float32
    bsz, t = z.shape[0], z.shape[1]
    c = RWKV_WIDTH
    hn = (RWKV_HEADS, HEAD_DIM)
    r = z[..., :c]
    k = z[..., c:2 * c]
    v = z[..., 2 * c:3 * c]
    o = 3 * c
    wl = z[..., o:o + DECAY_RANK]
    o += DECAY_RANK
    al = z[..., o:o + ICLR_RANK]
    o += ICLR_RANK
    gl = z[..., o:o + GATE_RANK]
    w_raw = (w0[:, None, None, :] + jnp.einsum('btr,drc->dbtc', jnp.tanh(wl), w2)).astype(f32)
    decay = jnp.exp(-jnp.exp(-jax.nn.softplus(-w_raw) - 0.5))
    a = jax.nn.sigmoid((a0[:, None, None, :] + jnp.einsum('btr,drc->dbtc', al, a2)).astype(f32))
    g = (jax.nn.sigmoid(gl) @ g2).astype(f32)
    kk = (k * k_k).astype(f32).reshape(bsz, t, *hn)
    kk = kk / jnp.maximum(jnp.sqrt(jnp.sum(kk * kk, axis=-1, keepdims=True)), 1e-12)
    k_dir = (k.astype(f32)[None] * (1.0 + (a - 1.0) * k_a.astype(f32))).reshape(2, bsz, t, *hn)
    a_h = a.reshape(2, bsz, t, *hn)
    rh = r.astype(f32).reshape(bsz, t, *hn)
    vh = v.astype(f32).reshape(bsz, t, *hn)

    def orient(u):
        return jnp.stack([u[0], jnp.flip(u[1], axis=1)])

    def both(u):
        return jnp.stack([u, jnp.flip(u, axis=1)])

    ys = rwkv7_bidir_scan(both(rh), orient(decay.reshape(2, bsz, t, *hn)), orient(k_dir),
                          both(vh), both(-kk), orient(kk[None] * a_h))
    y = ys[0] + jnp.flip(ys[1], axis=1)
    mu = jnp.mean(y, axis=-1, keepdims=True)
    var = jnp.mean(jnp.square(y - mu), axis=-1, keepdims=True)
    y = ((y - mu) * lax.rsqrt(var + GN_EPS)).reshape(bsz, t, c) * lnx_w.astype(f32) + lnx_b.astype(f32)
    bonus = jnp.einsum('bthn,dbthn,dhn->bth', rh, k_dir, r_k.astype(f32))[..., None] * vh
    out = (y + bonus.reshape(bsz, t, c)) * g
    return out.astype(z.dtype)


def setup_inputs(seed: int = 0) -> dict:
    key = jax.random.key(seed)
    ks = jax.random.split(key, 32)
    f32 = jnp.float32
    L = DEPTH

    def nrm(k, shape, scale):
        return jax.random.normal(k, shape, f32) * scale

    def gain(k, shape):
        return 1.0 + 0.05 * jax.random.normal(k, shape, f32)

    return {
        'x': nrm(ks[0], (BATCH, SEQ, D_MODEL), 1.0),
        'p': nrm(ks[1], (DEPTH, BATCH, SEQ, PLE_DIM), 1.0),
        'norm_mix': gain(ks[2], (L, D_MODEL)),
        'w_in': nrm(ks[3], (L, D_MODEL, IN_COLS), D_MODEL ** -0.5),
        'shift_mu': jax.random.uniform(ks[4], (L, RWKV_COLS), f32),
        'q_norm': gain(ks[5], (L, HEAD_DIM)),
        'k_norm': gain(ks[6], (L, HEAD_DIM)),
        'sink': nrm(ks[7], (L, ATTN_Q_HEADS), 0.5),
        'w0': jax.random.uniform(ks[8], (L, 2, RWKV_WIDTH), f32, minval=-6.0, maxval=1.0),
        'w2': nrm(ks[9], (L, 2, DECAY_RANK, RWKV_WIDTH), 0.1),
        'a0': nrm(ks[10], (L, 2, RWKV_WIDTH), 0.5),
        'a2': nrm(ks[11], (L, 2, ICLR_RANK, RWKV_WIDTH), ICLR_RANK ** -0.5),
        'g2': nrm(ks[12], (L, GATE_RANK, RWKV_WIDTH), GATE_RANK ** -0.5),
        'k_k': 0.85 + 0.05 * jax.random.normal(ks[13], (L, RWKV_WIDTH), f32),
        'k_a': gain(ks[14], (L, RWKV_WIDTH)),
        'r_k': nrm(ks[15], (L, 2, RWKV_HEADS, HEAD_DIM), 0.1),
        'lnx_w': gain(ks[16], (L, RWKV_WIDTH)),
        'lnx_b': nrm(ks[17], (L, RWKV_WIDTH), 0.02),
        'w_up_attn': nrm(ks[18], (L, ATTN_WIDTH, D_MODEL), ATTN_WIDTH ** -0.5),
        'w_up_rwkv': nrm(ks[19], (L, RWKV_WIDTH, D_MODEL), RWKV_WIDTH ** -0.5),
        'w_out': nrm(ks[20], (L, D_MODEL, D_MODEL), D_MODEL ** -0.5),
        'norm_ffn': gain(ks[21], (L, D_MODEL)),
        'w_ff1': nrm(ks[22], (L, D_MODEL, D_FF), D_MODEL ** -0.5),
        'w_ff2': nrm(ks[23], (L, D_FF, D_MODEL), D_FF ** -0.5),
        'norm_ple': gain(ks[24], (L, D_MODEL)),
        'w_ple_gate': nrm(ks[25], (L, D_MODEL, D_MODEL), D_MODEL ** -0.5),
        'w_ple': nrm(ks[26], (L, PLE_DIM, D_MODEL), PLE_DIM ** -0.5),
    }


def reference(x, p, norm_mix, w_in, shift_mu, q_norm, k_norm, sink, w0, w2, a0, a2, g2,
              k_k, k_a, r_k, lnx_w, lnx_b, w_up_attn, w_up_rwkv, w_out, norm_ffn,
              w_ff1, w_ff2, norm_ple, w_ple_gate, w_ple):
    bsz, s = x.shape[0], x.shape[1]
    positions = jnp.arange(s)
    for i in range(DEPTH):
        h = rms_norm(x, norm_mix[i])
        proj = h @ w_in[i]
        q = proj[..., O_Q:O_K].reshape(bsz, s, ATTN_Q_HEADS, HEAD_DIM)
        k = proj[..., O_K:O_V].reshape(bsz, s, ATTN_KV_HEADS, HEAD_DIM)
        v = proj[..., O_V:O_RWKV].reshape(bsz, s, ATTN_KV_HEADS, HEAD_DIM)
        q = rotary_partial(rms_norm(q, q_norm[i]), positions)
        k = rotary_partial(rms_norm(k, k_norm[i]), positions)
        attn = windowed_gqa(q, k, v, sink[i])
        zr = proj[..., O_RWKV:O_GATE]
        zr = zr + shift_mu[i] * (centred_shift(zr) - zr)
        rw = rwkv7_time_mix(zr, w0[i], w2[i], a0[i], a2[i], g2[i], k_k[i], k_a[i],
                            r_k[i], lnx_w[i], lnx_b[i])
        gates = jax.nn.sigmoid(proj[..., O_GATE:].reshape(bsz, s, N_BRANCH, D_MODEL))
        merged = gates[..., 0, :] * (attn @ w_up_attn[i]) + gates[..., 1, :] * (rw @ w_up_rwkv[i])
        x = x + merged @ w_out[i]
        hf = rms_norm(x, norm_ffn[i])
        x = x + jnp.square(jax.nn.relu(hf @ w_ff1[i])) @ w_ff2[i]
        hp = rms_norm(x, norm_ple[i])
        x = x + (p[i] @ w_ple[i]) * jax.nn.sigmoid(hp @ w_ple_gate[i])
    return x
```

```cpp
#include <hip/hip_runtime.h>
#include <hip/hip_cooperative_groups.h>
#include <cstdio>
namespace cg = cooperative_groups;

#define DI __device__ __forceinline__
typedef unsigned short u16;
using bf16x8 = __attribute__((ext_vector_type(8))) short;
using f32x4 = __attribute__((ext_vector_type(4))) float;

constexpr int T = 16384, S = 4096;
constexpr int NTHR = 512;
constexpr int LDS_BYTES = 110592;
#ifndef ONE_LAUNCH
#define ONE_LAUNCH 0
#endif

constexpr size_t WT_IN = 0, WT_UA = 4718592, WT_UR = 5242880, WT_OUT = 5767168, WT_FF1 = 6815744,
                 WT_FF2 = 11010048, WT_PG = 15204352, WT_PL = 16252928;
constexpr size_t ROT_OFF = 33030144;
constexpr size_t QKV_OFF = 33554432;
constexpr size_t K_OFF = QKV_OFF + 16777216, VT_OFF = K_OFF + 4194304;
constexpr size_t ZR_OFF = 58720256;
constexpr size_t GATES_OFF = 117440512;
constexpr size_t ATTN_OFF = 184549376;
constexpr size_t Y_OFF = 201326592;
constexpr size_t RW_OFF = QKV_OFF;
constexpr size_t MERGED_OFF = ZR_OFF;
constexpr size_t HF_OFF = Y_OFF;
constexpr size_t HID_OFF = QKV_OFF;
constexpr size_t HP_OFF = Y_OFF + 33554432;
constexpr size_t PB_OFF = ATTN_OFF;
constexpr size_t PE_OFF = QKV_OFF;

struct Params {
  const float *x, *p, *norm_mix, *w_in, *shift_mu, *q_norm, *k_norm, *sink, *w0, *w2, *a0, *a2, *g2, *k_k, *k_a,
      *r_k, *lnx_w, *lnx_b, *w_up_attn, *w_up_rwkv, *w_out, *norm_ffn, *w_ff1, *w_ff2, *norm_ple, *w_ple_gate, *w_ple;
  float* out;
  char* ws;
};

DI u16 f2bf(float x) { unsigned u = __float_as_uint(x); u += 0x7fffu + ((u >> 16) & 1u); return (u16)(u >> 16); }
DI float bf2f(u16 h) { return __uint_as_float(((unsigned)h) << 16); }
DI unsigned pack2(float a, float b) { return (unsigned)f2bf(a) | ((unsigned)f2bf(b) << 16); }
DI float sigmoidf(float x) { return 1.f / (1.f + __expf(-x)); }
DI float wave_sum(float v) { for (int m = 32; m >= 1; m >>= 1) v += __shfl_xor(v, m); return v; }
DI float wave_max(float v) { for (int m = 32; m >= 1; m >>= 1) v = fmaxf(v, __shfl_xor(v, m)); return v; }
template <int CTRL> DI float dppf(float x) {
  return __int_as_float(__builtin_amdgcn_update_dpp(0, __float_as_int(x), CTRL, 0xF, 0xF, true));
}
DI float row16_sum(float v) {
  v += dppf<0xB1>(v);
  v += dppf<0x4E>(v);
  v += dppf<0x141>(v);
  v += dppf<0x140>(v);
  return v;
}
DI float zshift(const u16* ZR, int t, int s, int col, float mu) {
  float z = bf2f(ZR[(size_t)t * 1792 + col]);
  float pv = s > 0 ? bf2f(ZR[(size_t)(t - 1) * 1792 + col]) : 0.f;
  float nx = s < S - 1 ? bf2f(ZR[(size_t)(t + 1) * 1792 + col]) : 0.f;
  return z + mu * (0.5f * (pv + nx) - z);
}

DI void p0_prep(const Params& P, char* smem) {
  const int tid = threadIdx.x;
  float* tile = (float*)smem;
  u16* WB = (u16*)P.ws;
  for (int t = blockIdx.x; t < 4032; t += gridDim.x) {
    const float* src; u16* dst; int K, N, lt;
    if (t < 1152) { src = P.w_in; dst = WB + WT_IN; K = 1024; N = 4608; lt = t; }
    else if (t < 1280) { src = P.w_up_attn; dst = WB + WT_UA; K = 512; N = 1024; lt = t - 1152; }
    else if (t < 1408) { src = P.w_up_rwkv; dst = WB + WT_UR; K = 512; N = 1024; lt = t - 1280; }
    else if (t < 1664) { src = P.w_out; dst = WB + WT_OUT; K = 1024; N = 1024; lt = t - 1408; }
    else if (t < 2688) { src = P.w_ff1; dst = WB + WT_FF1; K = 1024; N = 4096; lt = t - 1664; }
    else if (t < 3712) { src = P.w_ff2; dst = WB + WT_FF2; K = 4096; N = 1024; lt = t - 2688; }
    else if (t < 3968) { src = P.w_ple_gate; dst = WB + WT_PG; K = 1024; N = 1024; lt = t - 3712; }
    else { src = P.w_ple; dst = WB + WT_PL; K = 256; N = 1024; lt = t - 3968; }
    const int ntn = N >> 6, k0 = (lt / ntn) * 64, n0 = (lt % ntn) * 64;
#pragma unroll
    for (int i = 0; i < 8; ++i) { int idx = i * NTHR + tid, r = idx >> 6, c = idx & 63; tile[r * 65 + c] = src[(size_t)(k0 + r) * N + n0 + c]; }
    __syncthreads();
#pragma unroll
    for (int i = 0; i < 8; ++i) { int idx = i * NTHR + tid, n = idx >> 6, k = idx & 63; dst[(size_t)(n0 + n) * K + k0 + k] = f2bf(tile[k * 65 + n]); }
    __syncthreads();
  }
  float* ROT = (float*)(P.ws + ROT_OFF);
  for (int e = blockIdx.x * NTHR + tid; e < 32768; e += gridDim.x * NTHR) {
    int pos = e >> 3, i = e & 7;
    float invf = i == 0 ? 1.0f : i == 1 ? 0.19392274f : i == 2 ? 0.03760603f : i == 3 ? 0.0072926646f
               : i == 4 ? 0.0014142136f : i == 5 ? 0.0002742482f : i == 6 ? 5.3182957e-05f : 1.0313385e-05f;
    float ang = (float)pos * invf;
    double a = (double)ang;
    double kq = rint(a * 0.15915494309189535);
    float rf = (float)(a - kq * 6.283185307179586476925);
    ROT[e] = cosf(rf); ROT[32768 + e] = sinf(rf);
  }
}

DI void rmsnorm_rows(const float* src, const float* gain, u16* dst) {
  const int tid = threadIdx.x, lane = tid & 63;
  for (int row = blockIdx.x * 8 + (tid >> 6); row < T; row += gridDim.x * 8) {
    const float4* s4 = (const float4*)(src + (size_t)row * 1024);
    float4 v[4]; float ss = 0.f;
#pragma unroll
    for (int i = 0; i < 4; ++i) { v[i] = s4[lane + i * 64]; ss += v[i].x * v[i].x + v[i].y * v[i].y + v[i].z * v[i].z + v[i].w * v[i].w; }
    ss = wave_sum(ss);
    float sc = rsqrtf(ss * (1.f / 1024.f) + 1e-6f);
#pragma unroll
    for (int i = 0; i < 4; ++i) {
      float4 g = ((const float4*)gain)[lane + i * 64];
      uint2 o; o.x = pack2(v[i].x * sc * g.x, v[i].y * sc * g.y); o.y = pack2(v[i].z * sc * g.z, v[i].w * sc * g.w);
      *(uint2*)(dst + (size_t)row * 1024 + (lane + i * 64) * 4) = o;
    }
  }
}

#define MFMA16(a, b, c) __builtin_amdgcn_mfma_f32_16x16x32_bf16((a), (b), (c), 0, 0, 0)
constexpr int LDT = 72;
DI void gemm_main(const u16* __restrict__ A, int lda, const u16* __restrict__ Bt, int ldb, int K, int m0, int n0,
                  f32x4 (&acc)[4][4], char* smem) {
  const int tid = threadIdx.x, lane = tid & 63, w = tid >> 6, wm = w >> 1, wn = w & 1;
  u16* As = (u16*)smem;
  u16* Bs = As + 2 * 256 * LDT;
  const int nk = K >> 6;
  const int lrow = tid >> 3, lkc = (tid & 7) * 8;
  const u16* Ag = A + (size_t)(m0 + lrow) * lda + lkc;
  const u16* Bg = Bt + (size_t)(n0 + lrow) * ldb + lkc;
  uint4 ra[4], rb[2];
#define GLOAD(kt) do { \
    _Pragma("unroll") for (int i = 0; i < 4; ++i) ra[i] = *(const uint4*)(Ag + (size_t)(i * 64) * lda + (kt) * 64); \
    _Pragma("unroll") for (int i = 0; i < 2; ++i) rb[i] = *(const uint4*)(Bg + (size_t)(i * 64) * ldb + (kt) * 64); } while (0)
#define SSTORE(buf) do { \
    _Pragma("unroll") for (int i = 0; i < 4; ++i) *(uint4*)(As + (buf) * 256 * LDT + (lrow + i * 64) * LDT + lkc) = ra[i]; \
    _Pragma("unroll") for (int i = 0; i < 2; ++i) *(uint4*)(Bs + (buf) * 128 * LDT + (lrow + i * 64) * LDT + lkc) = rb[i]; } while (0)
  GLOAD(0); SSTORE(0);
  __syncthreads();
  const int fr = lane & 15, fq = (lane >> 4) * 8;
  for (int kt = 0; kt < nk; ++kt) {
    const int buf = kt & 1;
    if (kt + 1 < nk) GLOAD(kt + 1);
    const u16* Asb = As + buf * 256 * LDT + (wm * 64 + fr) * LDT + fq;
    const u16* Bsb = Bs + buf * 128 * LDT + (wn * 64 + fr) * LDT + fq;
#pragma unroll
    for (int ks = 0; ks < 2; ++ks) {
      bf16x8 af[4], bfr[4];
#pragma unroll
      for (int i = 0; i < 4; ++i) af[i] = *(const bf16x8*)(Asb + i * 16 * LDT + ks * 32);
#pragma unroll
      for (int j = 0; j < 4; ++j) bfr[j] = *(const bf16x8*)(Bsb + j * 16 * LDT + ks * 32);
#pragma unroll
      for (int i = 0; i < 4; ++i)
#pragma unroll
        for (int j = 0; j < 4; ++j) acc[i][j] = MFMA16(af[i], bfr[j], acc[i][j]);
    }
    if (kt + 1 < nk) SSTORE(buf ^ 1);
    __syncthreads();
  }
#undef GLOAD
#undef SSTORE
}
DI void zero_acc(f32x4 (&acc)[4][4]) {
#pragma unroll
  for (int i = 0; i < 4; ++i)
#pragma unroll
    for (int j = 0; j < 4; ++j) acc[i][j] = f32x4{0.f, 0.f, 0.f, 0.f};
}
#define EPI_LOOP(BODY) do { const int lane_ = threadIdx.x & 63, w_ = threadIdx.x >> 6; \
    const int rb_ = m0 + (w_ >> 1) * 64 + (lane_ >> 4) * 4, cb_ = n0 + (w_ & 1) * 64 + (lane_ & 15); \
    _Pragma("unroll") for (int i = 0; i < 4; ++i) { _Pragma("unroll") for (int j = 0; j < 4; ++j) { \
      _Pragma("unroll") for (int r = 0; r < 4; ++r) { const int row = rb_ + i * 16 + r, col = cb_ + j * 16; BODY } } \
      __builtin_amdgcn_sched_barrier(0); } } while (0)

DI void p1_proj(const Params& P, char* smem) {
  const u16* H = (const u16*)P.out;
  const u16* Wt = (const u16*)P.ws + WT_IN;
  u16* Q = (u16*)(P.ws + QKV_OFF); u16* Kb = (u16*)(P.ws + K_OFF); u16* VT = (u16*)(P.ws + VT_OFF);
  u16* ZR = (u16*)(P.ws + ZR_OFF); u16* GT = (u16*)(P.ws + GATES_OFF);
  for (int t = blockIdx.x; t < 64 * 36; t += gridDim.x) {
    const int m0 = (t / 36) * 256, n0 = (t % 36) * 128;
    f32x4 acc[4][4]; zero_acc(acc);
    gemm_main(H, 1024, Wt, 1024, 1024, m0, n0, acc, smem);
    if (n0 < 512) { EPI_LOOP( Q[(size_t)row * 512 + col] = f2bf(acc[i][j][r]); ); }
    else if (n0 == 512) { EPI_LOOP( Kb[(size_t)row * 128 + (col - 512)] = f2bf(acc[i][j][r]); ); }
    else if (n0 == 640) {
      const int lane = threadIdx.x & 63, w = threadIdx.x >> 6;
      const int rb = m0 + (w >> 1) * 64 + (lane >> 4) * 4, cb = (w & 1) * 64 + (lane & 15);
#pragma unroll
      for (int i = 0; i < 4; ++i)
#pragma unroll
        for (int j = 0; j < 4; ++j) {
          const int row = rb + i * 16, c = cb + j * 16;
          const int b = row >> 12, s = row & 4095, kvh = c >> 6, d = c & 63;
          uint2 o; o.x = pack2(acc[i][j][0], acc[i][j][1]); o.y = pack2(acc[i][j][2], acc[i][j][3]);
          *(uint2*)(VT + ((size_t)((b * 2 + kvh) * 64 + d)) * 4096 + s) = o;
        }
    }
    else if (n0 < 2560) { EPI_LOOP( ZR[(size_t)row * 1792 + (col - 768)] = f2bf(acc[i][j][r]); ); }
    else { EPI_LOOP( GT[(size_t)row * 2048 + (col - 2560)] = f2bf(sigmoidf(acc[i][j][r])); ); }
  }
}

DI void p1b_qknorm(const Params& P) {
  const int tid = threadIdx.x, lane = tid & 63;
  u16* Q = (u16*)(P.ws + QKV_OFF); u16* Kb = (u16*)(P.ws + K_OFF);
  const float* ROT = (const float*)(P.ws + ROT_OFF);
  const float gq = P.q_norm[lane], gk = P.k_norm[lane];
  for (int it = blockIdx.x * 8 + (tid >> 6); it < T * 10; it += gridDim.x * 8) {
    const int t = it / 10, hs = it % 10, s = t & 4095;
    u16* ptr = hs < 8 ? Q + (size_t)t * 512 + hs * 64 + lane : Kb + (size_t)t * 128 + (hs - 8) * 64 + lane;
    float v = bf2f(*ptr);
    float ss = wave_sum(v * v);
    float y = v * rsqrtf(ss * (1.f / 64.f) + 1e-6f) * (hs < 8 ? gq : gk);
    float other = __shfl_xor(y, 8);
    if (lane < 16) {
      float c = ROT[s * 8 + (lane & 7)], sn = ROT[32768 + s * 8 + (lane & 7)];
      y = lane < 8 ? y * c - other * sn : y * c + other * sn;
    }
    *ptr = f2bf(y);
  }
}

DI void p2_attn_naive(const Params& P, char* smem) {
  const int tid = threadIdx.x, lane = tid & 63, w = tid >> 6;
  float* qs = (float*)smem + w * 400;
  float* ps = qs + 64;
  const u16* Q = (const u16*)(P.ws + QKV_OFF); const u16* Kb = (const u16*)(P.ws + K_OFF); const u16* VT = (const u16*)(P.ws + VT_OFF);
  u16* AT = (u16*)(P.ws + ATTN_OFF);
  const int nw = gridDim.x * 8, items = T * 8;
  const int iters = (items + nw - 1) / nw;
  for (int itn = 0; itn < iters; ++itn) {
    const int it = itn * nw + blockIdx.x * 8 + w;
    const bool act = it < items;
    const int t = act ? it >> 3 : 0, qh = it & 7, kvh = qh >> 2, b = t >> 12, s = t & 4095;
    const int klo = max(0, s - 128), khi = min(S - 1, s + 128);
    qs[lane] = bf2f(Q[(size_t)t * 512 + qh * 64 + lane]);
    __syncthreads();
    float sc[5]; float m = -1e30f;
#pragma unroll
    for (int r = 0; r < 5; ++r) {
      const int key = klo + r * 64 + lane;
      float dsum = -1e30f;
      if (key <= khi) {
        const uint4* kp = (const uint4*)(Kb + (size_t)(b * 4096 + key) * 128 + kvh * 64);
        float a = 0.f;
#pragma unroll
        for (int c = 0; c < 8; ++c) {
          uint4 kv = kp[c];
          unsigned uu[4] = {kv.x, kv.y, kv.z, kv.w};
#pragma unroll
          for (int e = 0; e < 4; ++e) {
            a += qs[c * 8 + e * 2] * __uint_as_float(uu[e] << 16);
            a += qs[c * 8 + e * 2 + 1] * __uint_as_float(uu[e] & 0xffff0000u);
          }
        }
        dsum = a * 0.125f;
      }
      sc[r] = dsum; m = fmaxf(m, dsum);
    }
    const float sk = P.sink[qh];
    m = fmaxf(wave_max(m), sk);
    float l = 0.f;
#pragma unroll
    for (int r = 0; r < 5; ++r) {
      const int key = klo + r * 64 + lane;
      float pv = key <= khi ? __expf(sc[r] - m) : 0.f;
      l += pv; ps[r * 64 + lane] = pv;
    }
    l = wave_sum(l) + __expf(sk - m);
    __syncthreads();
    const u16* vrow = VT + ((size_t)((b * 2 + kvh) * 64 + lane)) * 4096;
    float o = 0.f;
    for (int kc = klo & ~7; kc <= khi; kc += 8) {
      uint4 vv = *(const uint4*)(vrow + kc);
      unsigned uu[4] = {vv.x, vv.y, vv.z, vv.w};
#pragma unroll
      for (int e = 0; e < 4; ++e) {
        const int k0 = kc + e * 2, k1 = k0 + 1;
        float p0 = (k0 >= klo && k0 <= khi) ? ps[k0 - klo] : 0.f;
        float p1 = (k1 >= klo && k1 <= khi) ? ps[k1 - klo] : 0.f;
        o += p0 * __uint_as_float(uu[e] << 16) + p1 * __uint_as_float(uu[e] & 0xffff0000u);
      }
    }
    if (act) AT[(size_t)t * 512 + qh * 64 + lane] = f2bf(o / l);
    __syncthreads();
  }
}

DI void p2_prep(const Params& P, char* smem) {
  const int tid = threadIdx.x, c = tid;
  float* tw = (float*)smem;
  float* al = tw + 64 * 32;
  const u16* ZR = (const u16*)(P.ws + ZR_OFF);
  u16* SW = (u16*)P.out; u16* AA = SW + (size_t)2 * T * 512;
  for (int tile = blockIdx.x; tile < T / 32; tile += gridDim.x) {
    const int t0 = tile * 32;
#pragma unroll
    for (int i = 0; i < 8; ++i) {
      int idx = i * NTHR + tid, tt = idx >> 7, col = idx & 127, t = t0 + tt, zc = 1536 + col;
      float z = zshift(ZR, t, t & 4095, zc, P.shift_mu[zc]);
      if (col < 64) tw[col * 32 + tt] = tanhf(z); else al[(col - 64) * 32 + tt] = z;
    }
    __syncthreads();
#pragma unroll 1
    for (int d = 0; d < 2; ++d) {
      float accw[32], acca[32];
#pragma unroll
      for (int tt = 0; tt < 32; ++tt) { accw[tt] = 0.f; acca[tt] = 0.f; }
      const float* w2p = P.w2 + (size_t)d * 64 * 512 + c;
      const float* a2p = P.a2 + (size_t)d * 64 * 512 + c;
#pragma unroll 2
      for (int r = 0; r < 64; ++r) {
        const float wv = w2p[r * 512], av = a2p[r * 512];
#pragma unroll
        for (int q = 0; q < 8; ++q) {
          float4 x4 = *(const float4*)(tw + r * 32 + q * 4), y4 = *(const float4*)(al + r * 32 + q * 4);
          accw[q * 4 + 0] += x4.x * wv; accw[q * 4 + 1] += x4.y * wv; accw[q * 4 + 2] += x4.z * wv; accw[q * 4 + 3] += x4.w * wv;
          acca[q * 4 + 0] += y4.x * av; acca[q * 4 + 1] += y4.y * av; acca[q * 4 + 2] += y4.z * av; acca[q * 4 + 3] += y4.w * av;
        }
      }
      const float w0v = P.w0[d * 512 + c], a0v = P.a0[d * 512 + c];
#pragma unroll
      for (int tt = 0; tt < 32; ++tt) {
        SW[((size_t)d * T + t0 + tt) * 512 + c] = f2bf(0.60653066f * sigmoidf(w0v + accw[tt]));
        AA[((size_t)d * T + t0 + tt) * 512 + c] = f2bf(sigmoidf(a0v + acca[tt]));
      }
    }
    __syncthreads();
  }
}

DI void p3_scan(const Params& P, char* smem) {
  const int tid = threadIdx.x, lane = tid & 63, w = tid >> 6;
  float* NA = (float*)smem; float* Wd = NA + 2048; float* Bv = Wd + 2048; float* KD = Bv + 2048; float* Rr = KD + 2048;
  float* Vv = Rr + 2048;
  float* YS = Vv + 512;
  const u16* ZR = (const u16*)(P.ws + ZR_OFF);
  const u16* SW = (const u16*)P.out; const u16* AA = SW + (size_t)2 * T * 512;
  float* Y = (float*)(P.ws + Y_OFF);
  for (int item = blockIdx.x; item < 256; item += gridDim.x) {
    const int u = (item & 7) * 8 + (item >> 5), rq = (item >> 3) & 3;
    const int d = u >> 5, b = (u >> 3) & 3, h = u & 7;
    const int pj = tid >> 4, pc = (tid & 15) * 4;
    float mur[4], muk[4], muv[4], kkw[4], kaw[4];
#pragma unroll
    for (int e = 0; e < 4; ++e) {
      mur[e] = P.shift_mu[h * 64 + pc + e]; muk[e] = P.shift_mu[512 + h * 64 + pc + e]; muv[e] = P.shift_mu[1024 + h * 64 + pc + e];
      kkw[e] = P.k_k[h * 64 + pc + e]; kaw[e] = P.k_a[h * 64 + pc + e];
    }
    float s0 = 0.f, s1 = 0.f, s2 = 0.f, s3 = 0.f;
    const int rl = (w & 3) * 4 + (lane >> 4), jl = lane & 15;
    for (int ci = 0; ci < 128; ++ci) {
      {
        const int step = ci * 32 + pj, s = d ? (S - 1 - step) : step, t = b * S + s;
        const u16* zp = ZR + (size_t)t * 1792 + h * 64 + pc;
        float rr[4], kk[4], vv[4];
#pragma unroll
        for (int g = 0; g < 3; ++g) {
          uint2 cu = *(const uint2*)(zp + g * 512);
          uint2 pu = s > 0 ? *(const uint2*)(zp + g * 512 - 1792) : make_uint2(0u, 0u);
          uint2 nu = s < S - 1 ? *(const uint2*)(zp + g * 512 + 1792) : make_uint2(0u, 0u);
          unsigned cw[2] = {cu.x, cu.y}, pw[2] = {pu.x, pu.y}, nw2[2] = {nu.x, nu.y};
#pragma unroll
          for (int e = 0; e < 4; ++e) {
            float z = (e & 1) ? __uint_as_float(cw[e >> 1] & 0xffff0000u) : __uint_as_float(cw[e >> 1] << 16);
            float pv = (e & 1) ? __uint_as_float(pw[e >> 1] & 0xffff0000u) : __uint_as_float(pw[e >> 1] << 16);
            float nx = (e & 1) ? __uint_as_float(nw2[e >> 1] & 0xffff0000u) : __uint_as_float(nw2[e >> 1] << 16);
            float mu = g == 0 ? mur[e] : g == 1 ? muk[e] : muv[e];
            float val = z + mu * (0.5f * (pv + nx) - z);
            if (g == 0) rr[e] = val; else if (g == 1) kk[e] = val; else vv[e] = val;
          }
        }
        uint2 su = *(const uint2*)(SW + ((size_t)d * T + t) * 512 + h * 64 + pc);
        uint2 au = *(const uint2*)(AA + ((size_t)d * T + t) * 512 + h * 64 + pc);
        unsigned sw2[2] = {su.x, su.y}, aw2[2] = {au.x, au.y};
        float kq[4], n2 = 0.f;
#pragma unroll
        for (int e = 0; e < 4; ++e) { kq[e] = kk[e] * kkw[e]; n2 += kq[e] * kq[e]; }
        n2 = row16_sum(n2);
        const float inv = 1.f / fmaxf(sqrtf(n2), 1e-12f);
        float4 o_na, o_w, o_b, o_kd, o_r;
        float tna[4], tw_[4], tb[4], tkd[4];
#pragma unroll
        for (int e = 0; e < 4; ++e) {
          float sg = (e & 1) ? __uint_as_float(sw2[e >> 1] & 0xffff0000u) : __uint_as_float(sw2[e >> 1] << 16);
          float a = (e & 1) ? __uint_as_float(aw2[e >> 1] & 0xffff0000u) : __uint_as_float(aw2[e >> 1] << 16);
          float kn = kq[e] * inv;
          tna[e] = -kn; tw_[e] = __expf(-sg); tb[e] = kn * a; tkd[e] = kk[e] * (1.f + (a - 1.f) * kaw[e]);
        }
        o_na = make_float4(tna[0], tna[1], tna[2], tna[3]); o_w = make_float4(tw_[0], tw_[1], tw_[2], tw_[3]);
        o_b = make_float4(tb[0], tb[1], tb[2], tb[3]); o_kd = make_float4(tkd[0], tkd[1], tkd[2], tkd[3]);
        o_r = make_float4(rr[0], rr[1], rr[2], rr[3]);
        *(float4*)(NA + pj * 64 + pc) = o_na; *(float4*)(Wd + pj * 64 + pc) = o_w; *(float4*)(Bv + pj * 64 + pc) = o_b;
        *(float4*)(KD + pj * 64 + pc) = o_kd; *(float4*)(Rr + pj * 64 + pc) = o_r;
        if ((pc >> 4) == rq) *(float4*)(Vv + pj * 16 + (pc & 15)) = make_float4(vv[0], vv[1], vv[2], vv[3]);
      }
      __syncthreads();
      if (w < 4) {
#pragma unroll 4
        for (int j = 0; j < 32; ++j) {
          const float4 na = *(const float4*)(NA + j * 64 + jl * 4);
          const float4 wv = *(const float4*)(Wd + j * 64 + jl * 4);
          const float4 bv = *(const float4*)(Bv + j * 64 + jl * 4);
          const float4 kd = *(const float4*)(KD + j * 64 + jl * 4);
          const float4 rv = *(const float4*)(Rr + j * 64 + jl * 4);
          const float v = Vv[j * 16 + rl];
          float pa = s0 * na.x + s1 * na.y + s2 * na.z + s3 * na.w;
          pa = row16_sum(pa);
          s0 = s0 * wv.x + (pa * bv.x + v * kd.x);
          s1 = s1 * wv.y + (pa * bv.y + v * kd.y);
          s2 = s2 * wv.z + (pa * bv.z + v * kd.z);
          s3 = s3 * wv.w + (pa * bv.w + v * kd.w);
          float py = s0 * rv.x + s1 * rv.y + s2 * rv.z + s3 * rv.w;
          py = row16_sum(py);
          if (jl == 0) YS[j * 16 + rl] = py;
        }
      }
      __syncthreads();
      {
        const int step = ci * 32 + (tid >> 4), s = d ? (S - 1 - step) : step, t = b * S + s;
        Y[((size_t)d * T + t) * 512 + h * 64 + rq * 16 + (tid & 15)] = YS[tid];
      }
    }
    __syncthreads();
  }
}

DI void p4_final(const Params& P, char* smem) {
  const int tid = threadIdx.x, c = tid;
  float* sg = (float*)smem;
  const u16* ZR = (const u16*)(P.ws + ZR_OFF);
  const u16* AA = (const u16*)P.out + (size_t)2 * T * 512;
  const float* Y = (const float*)(P.ws + Y_OFF);
  u16* RW = (u16*)(P.ws + RW_OFF);
  const float mur = P.shift_mu[c], muk = P.shift_mu[512 + c], muv = P.shift_mu[1024 + c], ka = P.k_a[c];
  const float rk0 = P.r_k[c], rk1 = P.r_k[512 + c], lw = P.lnx_w[c], lb = P.lnx_b[c];
  for (int tile = blockIdx.x; tile < T / 32; tile += gridDim.x) {
    const int t0 = tile * 32;
#pragma unroll
    for (int i = 0; i < 8; ++i) {
      int idx = i * NTHR + tid, tt = idx >> 7, col = idx & 127, t = t0 + tt, zc = 1664 + col;
      sg[col * 32 + tt] = sigmoidf(zshift(ZR, t, t & 4095, zc, P.shift_mu[zc]));
    }
    __syncthreads();
    float accg[32];
#pragma unroll
    for (int tt = 0; tt < 32; ++tt) accg[tt] = 0.f;
#pragma unroll 2
    for (int r = 0; r < 128; ++r) {
      const float gv = P.g2[r * 512 + c];
#pragma unroll
      for (int q = 0; q < 8; ++q) {
        float4 x4 = *(const float4*)(sg + r * 32 + q * 4);
        accg[q * 4 + 0] += x4.x * gv; accg[q * 4 + 1] += x4.y * gv; accg[q * 4 + 2] += x4.z * gv; accg[q * 4 + 3] += x4.w * gv;
      }
    }
#pragma unroll
    for (int tt = 0; tt < 32; ++tt) {
      const int t = t0 + tt, s = t & 4095;
      const float r = zshift(ZR, t, s, c, mur), k = zshift(ZR, t, s, 512 + c, muk), v = zshift(ZR, t, s, 1024 + c, muv);
      const float a0 = bf2f(AA[(size_t)t * 512 + c]), a1 = bf2f(AA[((size_t)T + t) * 512 + c]);
      const float kd0 = k * (1.f + (a0 - 1.f) * ka), kd1 = k * (1.f + (a1 - 1.f) * ka);
      const float bonus = wave_sum(r * (kd0 * rk0 + kd1 * rk1));
      const float y = Y[(size_t)t * 512 + c] + Y[((size_t)T + t) * 512 + c];
      const float mu = wave_sum(y) * (1.f / 64.f);
      const float dv = y - mu;
      const float var = wave_sum(dv * dv) * (1.f / 64.f);
      const float yn = dv * rsqrtf(var + 64e-5f) * lw + lb;
      RW[(size_t)t * 512 + c] = f2bf((yn + bonus * v) * accg[tt]);
    }
    __syncthreads();
  }
}

DI void p5_merge(const Params& P, char* smem) {
  const u16* AT = (const u16*)(P.ws + ATTN_OFF); const u16* RW = (const u16*)(P.ws + RW_OFF);
  const u16* WB = (const u16*)P.ws; const u16* GT = (const u16*)(P.ws + GATES_OFF);
  u16* MG = (u16*)(P.ws + MERGED_OFF);
  for (int t = blockIdx.x; t < 64 * 8; t += gridDim.x) {
    const int m0 = (t / 8) * 256, n0 = (t % 8) * 128;
    f32x4 acc[4][4]; zero_acc(acc);
    gemm_main(AT, 512, WB + WT_UA, 512, 512, m0, n0, acc, smem);
    EPI_LOOP( MG[(size_t)row * 1024 + col] = f2bf(acc[i][j][r] * bf2f(GT[(size_t)row * 2048 + col])); );
  }
  for (int t = blockIdx.x; t < 64 * 8; t += gridDim.x) {
    const int m0 = (t / 8) * 256, n0 = (t % 8) * 128;
    f32x4 acc[4][4]; zero_acc(acc);
    gemm_main(RW, 512, WB + WT_UR, 512, 512, m0, n0, acc, smem);
    EPI_LOOP( const float g1 = bf2f(GT[(size_t)row * 2048 + 1024 + col]);
              MG[(size_t)row * 1024 + col] = f2bf(bf2f(MG[(size_t)row * 1024 + col]) + g1 * acc[i][j][r]); );
  }
}
DI void p6_outproj(const Params& P, char* smem) {
  const u16* MG = (const u16*)(P.ws + MERGED_OFF); const u16* WB = (const u16*)P.ws;
  for (int t = blockIdx.x; t < 64 * 8; t += gridDim.x) {
    const int m0 = (t / 8) * 256, n0 = (t % 8) * 128;
    f32x4 acc[4][4]; zero_acc(acc);
    gemm_main(MG, 1024, WB + WT_OUT, 1024, 1024, m0, n0, acc, smem);
    EPI_LOOP( P.out[(size_t)row * 1024 + col] = P.x[(size_t)row * 1024 + col] + acc[i][j][r]; );
  }
}
DI void p8_ff1(const Params& P, char* smem) {
  const u16* HF = (const u16*)(P.ws + HF_OFF); const u16* WB = (const u16*)P.ws; u16* HID = (u16*)(P.ws + HID_OFF);
  for (int t = blockIdx.x; t < 64 * 32; t += gridDim.x) {
    const int m0 = (t / 32) * 256, n0 = (t % 32) * 128;
    f32x4 acc[4][4]; zero_acc(acc);
    gemm_main(HF, 1024, WB + WT_FF1, 1024, 1024, m0, n0, acc, smem);
    EPI_LOOP( const float a = fmaxf(acc[i][j][r], 0.f); HID[(size_t)row * 4096 + col] = f2bf(a * a); );
  }
}
DI void p9_ff2(const Params& P, char* smem) {
  const u16* HID = (const u16*)(P.ws + HID_OFF); const u16* WB = (const u16*)P.ws;
  for (int t = blockIdx.x; t < 64 * 8; t += gridDim.x) {
    const int m0 = (t / 8) * 256, n0 = (t % 8) * 128;
    f32x4 acc[4][4]; zero_acc(acc);
    gemm_main(HID, 4096, WB + WT_FF2, 4096, 4096, m0, n0, acc, smem);
    EPI_LOOP( P.out[(size_t)row * 1024 + col] += acc[i][j][r]; );
  }
}
DI void p10_cvt_p(const Params& P) {
  u16* PB = (u16*)(P.ws + PB_OFF);
  const float4* p4 = (const float4*)P.p;
  for (int e = blockIdx.x * NTHR + threadIdx.x; e < T * 256 / 4; e += gridDim.x * NTHR) {
    float4 v = p4[e]; uint2 o; o.x = pack2(v.x, v.y); o.y = pack2(v.z, v.w);
    *(uint2*)(PB + (size_t)e * 4) = o;
  }
}
DI void p11_ple(const Params& P, char* smem) {
  const u16* PB = (const u16*)(P.ws + PB_OFF); const u16* HP = (const u16*)(P.ws + HP_OFF); const u16* WB = (const u16*)P.ws;
  u16* PE = (u16*)(P.ws + PE_OFF);
  for (int t = blockIdx.x; t < 64 * 8; t += gridDim.x) {
    const int m0 = (t / 8) * 256, n0 = (t % 8) * 128;
    f32x4 acc[4][4]; zero_acc(acc);
    gemm_main(PB, 256, WB + WT_PL, 256, 256, m0, n0, acc, smem);
    EPI_LOOP( PE[(size_t)row * 1024 + col] = f2bf(acc[i][j][r]); );
  }
  for (int t = blockIdx.x; t < 64 * 8; t += gridDim.x) {
    const int m0 = (t / 8) * 256, n0 = (t % 8) * 128;
    f32x4 acc[4][4]; zero_acc(acc);
    gemm_main(HP, 1024, WB + WT_PG, 1024, 1024, m0, n0, acc, smem);
    EPI_LOOP( P.out[(size_t)row * 1024 + col] += bf2f(PE[(size_t)row * 1024 + col]) * sigmoidf(acc[i][j][r]); );
  }
}

constexpr int NPHASE = 13;
__global__ void __launch_bounds__(NTHR) mega(Params P, int ph_lo, int ph_hi) {
  extern __shared__ __attribute__((aligned(16))) char smem[];
#define PHASE(n, body) if (ph_lo <= (n) && (n) < ph_hi) { body; if ((n) + 1 < ph_hi) cg::this_grid().sync(); }
  PHASE(0, p0_prep(P, smem); rmsnorm_rows(P.x, P.norm_mix, (u16*)P.out))
  PHASE(1, p1_proj(P, smem))
  PHASE(2, p1b_qknorm(P))
  PHASE(3, p2_attn_naive(P, smem); p2_prep(P, smem))
  PHASE(4, p3_scan(P, smem))
  PHASE(5, p4_final(P, smem))
  PHASE(6, p5_merge(P, smem))
  PHASE(7, p6_outproj(P, smem))
  PHASE(8, rmsnorm_rows(P.out, P.norm_ffn, (u16*)(P.ws + HF_OFF)))
  PHASE(9, p8_ff1(P, smem))
  PHASE(10, p9_ff2(P, smem))
  PHASE(11, rmsnorm_rows(P.out, P.norm_ple, (u16*)(P.ws + HP_OFF)); p10_cvt_p(P))
  PHASE(12, p11_ple(P, smem))
#undef PHASE
}

extern "C" void kernel_launch(void* const* d_in, const int* in_sizes, int n_in, void* d_out, int out_size, void* d_ws,
                              size_t ws_size, hipStream_t stream) {
  static int grid = 0;
  if (grid == 0) {
    int dev = 0, cus = 0, per_cu = 0;
    hipGetDevice(&dev);
    hipDeviceGetAttribute(&cus, hipDeviceAttributeMultiprocessorCount, dev);
    hipFuncSetAttribute((const void*)mega, hipFuncAttributeMaxDynamicSharedMemorySize, LDS_BYTES);
    hipOccupancyMaxActiveBlocksPerMultiprocessor(&per_cu, (const void*)mega, NTHR, LDS_BYTES);
    if (per_cu < 1) per_cu = 1;
    grid = cus * per_cu;
    if (ws_size < 268435456ull) fprintf(stderr, "kernel_launch: workspace too small: %zu\n", ws_size);
    fprintf(stderr, "kernel_launch: grid %d (cus %d x %d)\n", grid, cus, per_cu);
  }
  Params P{};
  const float** pp = (const float**)&P;
  for (int i = 0; i < 27; ++i) pp[i] = (const float*)d_in[i];
  P.out = (float*)d_out; P.ws = (char*)d_ws;
#if ONE_LAUNCH
  int lo = 0, hi = NPHASE;
  void* args[] = {&P, &lo, &hi};
  hipError_t e = hipLaunchCooperativeKernel((const void*)mega, dim3(grid), dim3(NTHR), args, LDS_BYTES, stream);
  if (e != hipSuccess) fprintf(stderr, "cooperative launch failed: %s\n", hipGetErrorString(e));
#else
  for (int ph = 0; ph < NPHASE; ++ph) hipLaunchKernelGGL(mega, dim3(grid), dim3(NTHR), LDS_BYTES, stream, P, ph, ph + 1);
#endif
}
```

```cpp
#include <hip/hip_runtime.h>
#include <hip/hip_cooperative_groups.h>
#include <cstdio>
namespace cg = cooperative_groups;

#define DI __device__ __forceinline__
typedef unsigned short u16;
using bf16x8 = __attribute__((ext_vector_type(8))) short;
using f32x4 = __attribute__((ext_vector_type(4))) float;

constexpr int T = 16384, S = 4096;
constexpr int NTHR = 512;
constexpr int LDS_BYTES = 110592;
#ifndef ONE_LAUNCH
#define ONE_LAUNCH 1
#endif

constexpr size_t WT_IN = 0, WT_UA = 4718592, WT_UR = 5242880, WT_OUT = 5767168, WT_FF1 = 6815744,
                 WT_FF2 = 11010048, WT_PG = 15204352, WT_PL = 16252928;
constexpr size_t ROT_OFF = 33030144;
constexpr size_t QKV_OFF = 33554432;
constexpr size_t K_OFF = QKV_OFF + 16777216, VT_OFF = K_OFF + 4194304;
constexpr size_t ZR_OFF = 58720256;
constexpr size_t GATES_OFF = 117440512;
constexpr size_t ATTN_OFF = 184549376;
constexpr size_t Y_OFF = 201326592;
constexpr size_t RW_OFF = QKV_OFF;
constexpr size_t MERGED_OFF = ZR_OFF;
constexpr size_t HF_OFF = Y_OFF;
constexpr size_t HID_OFF = QKV_OFF;
constexpr size_t HP_OFF = Y_OFF + 33554432;
constexpr size_t PB_OFF = ATTN_OFF;
constexpr size_t PE_OFF = QKV_OFF;

struct Params {
  const float *x, *p, *norm_mix, *w_in, *shift_mu, *q_norm, *k_norm, *sink, *w0, *w2, *a0, *a2, *g2, *k_k, *k_a,
      *r_k, *lnx_w, *lnx_b, *w_up_attn, *w_up_rwkv, *w_out, *norm_ffn, *w_ff1, *w_ff2, *norm_ple, *w_ple_gate, *w_ple;
  float* out;
  char* ws;
};

DI u16 f2bf(float x) { unsigned u = __float_as_uint(x); u += 0x7fffu + ((u >> 16) & 1u); return (u16)(u >> 16); }
DI float bf2f(u16 h) { return __uint_as_float(((unsigned)h) << 16); }
DI unsigned pack2(float a, float b) { return (unsigned)f2bf(a) | ((unsigned)f2bf(b) << 16); }
DI float sigmoidf(float x) { return 1.f / (1.f + __expf(-x)); }
DI float wave_sum(float v) { for (int m = 32; m >= 1; m >>= 1) v += __shfl_xor(v, m); return v; }
DI float wave_max(float v) { for (int m = 32; m >= 1; m >>= 1) v = fmaxf(v, __shfl_xor(v, m)); return v; }
template <int CTRL> DI float dppf(float x) {
  return __int_as_float(__builtin_amdgcn_update_dpp(0, __float_as_int(x), CTRL, 0xF, 0xF, true));
}
DI float row16_sum(float v) {
  v += dppf<0xB1>(v);
  v += dppf<0x4E>(v);
  v += dppf<0x141>(v);
  v += dppf<0x140>(v);
  return v;
}
DI float zshift(const u16* ZR, int t, int s, int col, float mu) {
  float z = bf2f(ZR[(size_t)t * 1792 + col]);
  float pv = s > 0 ? bf2f(ZR[(size_t)(t - 1) * 1792 + col]) : 0.f;
  float nx = s < S - 1 ? bf2f(ZR[(size_t)(t + 1) * 1792 + col]) : 0.f;
  return z + mu * (0.5f * (pv + nx) - z);
}

DI void p0_prep(const Params& P, char* smem) {
  const int tid = threadIdx.x;
  float* tile = (float*)smem;
  u16* WB = (u16*)P.ws;
  for (int t = blockIdx.x; t < 4032; t += gridDim.x) {
    const float* src; u16* dst; int K, N, lt;
    if (t < 1152) { src = P.w_in; dst = WB + WT_IN; K = 1024; N = 4608; lt = t; }
    else if (t < 1280) { src = P.w_up_attn; dst = WB + WT_UA; K = 512; N = 1024; lt = t - 1152; }
    else if (t < 1408) { src = P.w_up_rwkv; dst = WB + WT_UR; K = 512; N = 1024; lt = t - 1280; }
    else if (t < 1664) { src = P.w_out; dst = WB + WT_OUT; K = 1024; N = 1024; lt = t - 1408; }
    else if (t < 2688) { src = P.w_ff1; dst = WB + WT_FF1; K = 1024; N = 4096; lt = t - 1664; }
    else if (t < 3712) { src = P.w_ff2; dst = WB + WT_FF2; K = 4096; N = 1024; lt = t - 2688; }
    else if (t < 3968) { src = P.w_ple_gate; dst = WB + WT_PG; K = 1024; N = 1024; lt = t - 3712; }
    else { src = P.w_ple; dst = WB + WT_PL; K = 256; N = 1024; lt = t - 3968; }
    const int ntn = N >> 6, k0 = (lt / ntn) * 64, n0 = (lt % ntn) * 64;
#pragma unroll
    for (int i = 0; i < 8; ++i) { int idx = i * NTHR + tid, r = idx >> 6, c = idx & 63; tile[r * 65 + c] = src[(size_t)(k0 + r) * N + n0 + c]; }
    __syncthreads();
#pragma unroll
    for (int i = 0; i < 8; ++i) { int idx = i * NTHR + tid, n = idx >> 6, k = idx & 63; dst[(size_t)(n0 + n) * K + k0 + k] = f2bf(tile[k * 65 + n]); }
    __syncthreads();
  }
  float* ROT = (float*)(P.ws + ROT_OFF);
  for (int e = blockIdx.x * NTHR + tid; e < 32768; e += gridDim.x * NTHR) {
    int pos = e >> 3, i = e & 7;
    float invf = i == 0 ? 1.0f : i == 1 ? 0.19392274f : i == 2 ? 0.03760603f : i == 3 ? 0.0072926646f
               : i == 4 ? 0.0014142136f : i == 5 ? 0.0002742482f : i == 6 ? 5.3182957e-05f : 1.0313385e-05f;
    float ang = (float)pos * invf;
    double a = (double)ang;
    double kq = rint(a * 0.15915494309189535);
    float rf = (float)(a - kq * 6.283185307179586476925);
    ROT[e] = cosf(rf); ROT[32768 + e] = sinf(rf);
  }
}

DI void rmsnorm_rows(const float* src, const float* gain, u16* dst) {
  const int tid = threadIdx.x, lane = tid & 63;
  for (int row = blockIdx.x * 8 + (tid >> 6); row < T; row += gridDim.x * 8) {
    const float4* s4 = (const float4*)(src + (size_t)row * 1024);
    float4 v[4]; float ss = 0.f;
#pragma unroll
    for (int i = 0; i < 4; ++i) { v[i] = s4[lane + i * 64]; ss += v[i].x * v[i].x + v[i].y * v[i].y + v[i].z * v[i].z + v[i].w * v[i].w; }
    ss = wave_sum(ss);
    float sc = rsqrtf(ss * (1.f / 1024.f) + 1e-6f);
#pragma unroll
    for (int i = 0; i < 4; ++i) {
      float4 g = ((const float4*)gain)[lane + i * 64];
      uint2 o; o.x = pack2(v[i].x * sc * g.x, v[i].y * sc * g.y); o.y = pack2(v[i].z * sc * g.z, v[i].w * sc * g.w);
      *(uint2*)(dst + (size_t)row * 1024 + (lane + i * 64) * 4) = o;
    }
  }
}

#define MFMA16(a, b, c) __builtin_amdgcn_mfma_f32_16x16x32_bf16((a), (b), (c), 0, 0, 0)
constexpr int LDT = 72;
DI void gemm_main(const u16* __restrict__ A, int lda, const u16* __restrict__ Bt, int ldb, int K, int m0, int n0,
                  f32x4 (&acc)[4][4], char* smem) {
  const int tid = threadIdx.x, lane = tid & 63, w = tid >> 6, wm = w >> 1, wn = w & 1;
  u16* As = (u16*)smem;
  u16* Bs = As + 2 * 256 * LDT;
  const int nk = K >> 6;
  const int lrow = tid >> 3, lkc = (tid & 7) * 8;
  const u16* Ag = A + (size_t)(m0 + lrow) * lda + lkc;
  const u16* Bg = Bt + (size_t)(n0 + lrow) * ldb + lkc;
  uint4 ra[4], rb[2];
#define GLOAD(kt) do { \
    _Pragma("unroll") for (int i = 0; i < 4; ++i) ra[i] = *(const uint4*)(Ag + (size_t)(i * 64) * lda + (kt) * 64); \
    _Pragma("unroll") for (int i = 0; i < 2; ++i) rb[i] = *(const uint4*)(Bg + (size_t)(i * 64) * ldb + (kt) * 64); } while (0)
#define SSTORE(buf) do { \
    _Pragma("unroll") for (int i = 0; i < 4; ++i) *(uint4*)(As + (buf) * 256 * LDT + (lrow + i * 64) * LDT + lkc) = ra[i]; \
    _Pragma("unroll") for (int i = 0; i < 2; ++i) *(uint4*)(Bs + (buf) * 128 * LDT + (lrow + i * 64) * LDT + lkc) = rb[i]; } while (0)
  GLOAD(0); SSTORE(0);
  __syncthreads();
  const int fr = lane & 15, fq = (lane >> 4) * 8;
  for (int kt = 0; kt < nk; ++kt) {
    const int buf = kt & 1;
    if (kt + 1 < nk) GLOAD(kt + 1);
    const u16* Asb = As + buf * 256 * LDT + (wm * 64 + fr) * LDT + fq;
    const u16* Bsb = Bs + buf * 128 * LDT + (wn * 64 + fr) * LDT + fq;
#pragma unroll
    for (int ks = 0; ks < 2; ++ks) {
      bf16x8 af[4], bfr[4];
#pragma unroll
      for (int i = 0; i < 4; ++i) af[i] = *(const bf16x8*)(Asb + i * 16 * LDT + ks * 32);
#pragma unroll
      for (int j = 0; j < 4; ++j) bfr[j] = *(const bf16x8*)(Bsb + j * 16 * LDT + ks * 32);
#pragma unroll
      for (int i = 0; i < 4; ++i)
#pragma unroll
        for (int j = 0; j < 4; ++j) acc[i][j] = MFMA16(af[i], bfr[j], acc[i][j]);
    }
    if (kt + 1 < nk) SSTORE(buf ^ 1);
    __syncthreads();
  }
#undef GLOAD
#undef SSTORE
}
DI void zero_acc(f32x4 (&acc)[4][4]) {
#pragma unroll
  for (int i = 0; i < 4; ++i)
#pragma unroll
    for (int j = 0; j < 4; ++j) acc[i][j] = f32x4{0.f, 0.f, 0.f, 0.f};
}
#define EPI_LOOP(BODY) do { const int lane_ = threadIdx.x & 63, w_ = threadIdx.x >> 6; \
    const int rb_ = m0 + (w_ >> 1) * 64 + (lane_ >> 4) * 4, cb_ = n0 + (w_ & 1) * 64 + (lane_ & 15); \
    _Pragma("unroll") for (int i = 0; i < 4; ++i) { _Pragma("unroll") for (int j = 0; j < 4; ++j) { \
      _Pragma("unroll") for (int r = 0; r < 4; ++r) { const int row = rb_ + i * 16 + r, col = cb_ + j * 16; BODY } } \
      __builtin_amdgcn_sched_barrier(0); } } while (0)

DI void p1_proj(const Params& P, char* smem) {
  const u16* H = (const u16*)P.out;
  const u16* Wt = (const u16*)P.ws + WT_IN;
  u16* Q = (u16*)(P.ws + QKV_OFF); u16* Kb = (u16*)(P.ws + K_OFF); u16* VT = (u16*)(P.ws + VT_OFF);
  u16* ZR = (u16*)(P.ws + ZR_OFF); u16* GT = (u16*)(P.ws + GATES_OFF);
  for (int t = blockIdx.x; t < 64 * 36; t += gridDim.x) {
    const int m0 = (t / 36) * 256, n0 = (t % 36) * 128;
    f32x4 acc[4][4]; zero_acc(acc);
    gemm_main(H, 1024, Wt, 1024, 1024, m0, n0, acc, smem);
    if (n0 < 512) { EPI_LOOP( Q[(size_t)row * 512 + col] = f2bf(acc[i][j][r]); ); }
    else if (n0 == 512) { EPI_LOOP( Kb[(size_t)row * 128 + (col - 512)] = f2bf(acc[i][j][r]); ); }
    else if (n0 == 640) {
      const int lane = threadIdx.x & 63, w = threadIdx.x >> 6;
      const int rb = m0 + (w >> 1) * 64 + (lane >> 4) * 4, cb = (w & 1) * 64 + (lane & 15);
#pragma unroll
      for (int i = 0; i < 4; ++i)
#pragma unroll
        for (int j = 0; j < 4; ++j) {
          const int row = rb + i * 16, c = cb + j * 16;
          const int b = row >> 12, s = row & 4095, kvh = c >> 6, d = c & 63;
          uint2 o; o.x = pack2(acc[i][j][0], acc[i][j][1]); o.y = pack2(acc[i][j][2], acc[i][j][3]);
          *(uint2*)(VT + ((size_t)((b * 2 + kvh) * 64 + d)) * 4096 + s) = o;
        }
    }
    else if (n0 < 2560) { EPI_LOOP( ZR[(size_t)row * 1792 + (col - 768)] = f2bf(acc[i][j][r]); ); }
    else { EPI_LOOP( GT[(size_t)row * 2048 + (col - 2560)] = f2bf(sigmoidf(acc[i][j][r])); ); }
  }
}

DI void p1b_qknorm(const Params& P) {
  const int tid = threadIdx.x, lane = tid & 63;
  u16* Q = (u16*)(P.ws + QKV_OFF); u16* Kb = (u16*)(P.ws + K_OFF);
  const float* ROT = (const float*)(P.ws + ROT_OFF);
  const float gq = P.q_norm[lane], gk = P.k_norm[lane];
  for (int it = blockIdx.x * 8 + (tid >> 6); it < T * 10; it += gridDim.x * 8) {
    const int t = it / 10, hs = it % 10, s = t & 4095;
    u16* ptr = hs < 8 ? Q + (size_t)t * 512 + hs * 64 + lane : Kb + (size_t)t * 128 + (hs - 8) * 64 + lane;
    float v = bf2f(*ptr);
    float ss = wave_sum(v * v);
    float y = v * rsqrtf(ss * (1.f / 64.f) + 1e-6f) * (hs < 8 ? gq : gk);
    float other = __shfl_xor(y, 8);
    if (lane < 16) {
      float c = ROT[s * 8 + (lane & 7)], sn = ROT[32768 + s * 8 + (lane & 7)];
      y = lane < 8 ? y * c - other * sn : y * c + other * sn;
    }
    *ptr = f2bf(y);
  }
}

DI void p2_attn_naive(const Params& P, char* smem) {
  const int tid = threadIdx.x, lane = tid & 63, w = tid >> 6;
  float* qs = (float*)smem + w * 400;
  float* ps = qs + 64;
  const u16* Q = (const u16*)(P.ws + QKV_OFF); const u16* Kb = (const u16*)(P.ws + K_OFF); const u16* VT = (const u16*)(P.ws + VT_OFF);
  u16* AT = (u16*)(P.ws + ATTN_OFF);
  const int nw = gridDim.x * 8, items = T * 8;
  const int iters = (items + nw - 1) / nw;
  for (int itn = 0; itn < iters; ++itn) {
    const int it = itn * nw + blockIdx.x * 8 + w;
    const bool act = it < items;
    const int t = act ? it >> 3 : 0, qh = it & 7, kvh = qh >> 2, b = t >> 12, s = t & 4095;
    const int klo = max(0, s - 128), khi = min(S - 1, s + 128);
    qs[lane] = bf2f(Q[(size_t)t * 512 + qh * 64 + lane]);
    __syncthreads();
    float sc[5]; float m = -1e30f;
#pragma unroll
    for (int r = 0; r < 5; ++r) {
      const int key = klo + r * 64 + lane;
      float dsum = -1e30f;
      if (key <= khi) {
        const uint4* kp = (const uint4*)(Kb + (size_t)(b * 4096 + key) * 128 + kvh * 64);
        float a = 0.f;
#pragma unroll
        for (int c = 0; c < 8; ++c) {
          uint4 kv = kp[c];
          unsigned uu[4] = {kv.x, kv.y, kv.z, kv.w};
#pragma unroll
          for (int e = 0; e < 4; ++e) {
            a += qs[c * 8 + e * 2] * __uint_as_float(uu[e] << 16);
            a += qs[c * 8 + e * 2 + 1] * __uint_as_float(uu[e] & 0xffff0000u);
          }
        }
        dsum = a * 0.125f;
      }
      sc[r] = dsum; m = fmaxf(m, dsum);
    }
    const float sk = P.sink[qh];
    m = fmaxf(wave_max(m), sk);
    float l = 0.f;
#pragma unroll
    for (int r = 0; r < 5; ++r) {
      const int key = klo + r * 64 + lane;
      float pv = key <= khi ? __expf(sc[r] - m) : 0.f;
      l += pv; ps[r * 64 + lane] = pv;
    }
    l = wave_sum(l) + __expf(sk - m);
    __syncthreads();
    const u16* vrow = VT + ((size_t)((b * 2 + kvh) * 64 + lane)) * 4096;
    float o = 0.f;
    for (int kc = klo & ~7; kc <= khi; kc += 8) {
      uint4 vv = *(const uint4*)(vrow + kc);
      unsigned uu[4] = {vv.x, vv.y, vv.z, vv.w};
#pragma unroll
      for (int e = 0; e < 4; ++e) {
        const int k0 = kc + e * 2, k1 = k0 + 1;
        float p0 = (k0 >= klo && k0 <= khi) ? ps[k0 - klo] : 0.f;
        float p1 = (k1 >= klo && k1 <= khi) ? ps[k1 - klo] : 0.f;
        o += p0 * __uint_as_float(uu[e] << 16) + p1 * __uint_as_float(uu[e] & 0xffff0000u);
      }
    }
    if (act) AT[(size_t)t * 512 + qh * 64 + lane] = f2bf(o / l);
    __syncthreads();
  }
}

DI void p2_prep(const Params& P, char* smem) {
  const int tid = threadIdx.x, c = tid;
  float* tw = (float*)smem;
  float* al = tw + 64 * 32;
  const u16* ZR = (const u16*)(P.ws + ZR_OFF);
  u16* SW = (u16*)P.out; u16* AA = SW + (size_t)2 * T * 512;
  for (int tile = blockIdx.x; tile < T / 32; tile += gridDim.x) {
    const int t0 = tile * 32;
#pragma unroll
    for (int i = 0; i < 8; ++i) {
      int idx = i * NTHR + tid, tt = idx >> 7, col = idx & 127, t = t0 + tt, zc = 1536 + col;
      float z = zshift(ZR, t, t & 4095, zc, P.shift_mu[zc]);
      if (col < 64) tw[col * 32 + tt] = tanhf(z); else al[(col - 64) * 32 + tt] = z;
    }
    __syncthreads();
#pragma unroll 1
    for (int d = 0; d < 2; ++d) {
      float accw[32], acca[32];
#pragma unroll
      for (int tt = 0; tt < 32; ++tt) { accw[tt] = 0.f; acca[tt] = 0.f; }
      const float* w2p = P.w2 + (size_t)d * 64 * 512 + c;
      const float* a2p = P.a2 + (size_t)d * 64 * 512 + c;
#pragma unroll 2
      for (int r = 0; r < 64; ++r) {
        const float wv = w2p[r * 512], av = a2p[r * 512];
#pragma unroll
        for (int q = 0; q < 8; ++q) {
          float4 x4 = *(const float4*)(tw + r * 32 + q * 4), y4 = *(const float4*)(al + r * 32 + q * 4);
          accw[q * 4 + 0] += x4.x * wv; accw[q * 4 + 1] += x4.y * wv; accw[q * 4 + 2] += x4.z * wv; accw[q * 4 + 3] += x4.w * wv;
          acca[q * 4 + 0] += y4.x * av; acca[q * 4 + 1] += y4.y * av; acca[q * 4 + 2] += y4.z * av; acca[q * 4 + 3] += y4.w * av;
        }
      }
      const float w0v = P.w0[d * 512 + c], a0v = P.a0[d * 512 + c];
#pragma unroll
      for (int tt = 0; tt < 32; ++tt) {
        SW[((size_t)d * T + t0 + tt) * 512 + c] = f2bf(0.60653066f * sigmoidf(w0v + accw[tt]));
        AA[((size_t)d * T + t0 + tt) * 512 + c] = f2bf(sigmoidf(a0v + acca[tt]));
      }
    }
    __syncthreads();
  }
}

DI void p3_scan(const Params& P, char* smem) {
  const int tid = threadIdx.x, lane = tid & 63, w = tid >> 6;
  float* NA = (float*)smem; float* Wd = NA + 2048; float* Bv = Wd + 2048; float* KD = Bv + 2048; float* Rr = KD + 2048;
  float* Vv = Rr + 2048;
  float* YS = Vv + 512;
  const u16* ZR = (const u16*)(P.ws + ZR_OFF);
  const u16* SW = (const u16*)P.out; const u16* AA = SW + (size_t)2 * T * 512;
  float* Y = (float*)(P.ws + Y_OFF);
  for (int item = blockIdx.x; item < 256; item += gridDim.x) {
    const int u = (item & 7) * 8 + (item >> 5), rq = (item >> 3) & 3;
    const int d = u >> 5, b = (u >> 3) & 3, h = u & 7;
    const int pj = tid >> 4, pc = (tid & 15) * 4;
    float mur[4], muk[4], muv[4], kkw[4], kaw[4];
#pragma unroll
    for (int e = 0; e < 4; ++e) {
      mur[e] = P.shift_mu[h * 64 + pc + e]; muk[e] = P.shift_mu[512 + h * 64 + pc + e]; muv[e] = P.shift_mu[1024 + h * 64 + pc + e];
      kkw[e] = P.k_k[h * 64 + pc + e]; kaw[e] = P.k_a[h * 64 + pc + e];
    }
    float s0 = 0.f, s1 = 0.f, s2 = 0.f, s3 = 0.f;
    const int rl = (w & 3) * 4 + (lane >> 4), jl = lane & 15;
    for (int ci = 0; ci < 128; ++ci) {
      {
        const int step = ci * 32 + pj, s = d ? (S - 1 - step) : step, t = b * S + s;
        const u16* zp = ZR + (size_t)t * 1792 + h * 64 + pc;
        float rr[4], kk[4], vv[4];
#pragma unroll
        for (int g = 0; g < 3; ++g) {
          uint2 cu = *(const uint2*)(zp + g * 512);
          uint2 pu = s > 0 ? *(const uint2*)(zp + g * 512 - 1792) : make_uint2(0u, 0u);
          uint2 nu = s < S - 1 ? *(const uint2*)(zp + g * 512 + 1792) : make_uint2(0u, 0u);
          unsigned cw[2] = {cu.x, cu.y}, pw[2] = {pu.x, pu.y}, nw2[2] = {nu.x, nu.y};
#pragma unroll
          for (int e = 0; e < 4; ++e) {
            float z = (e & 1) ? __uint_as_float(cw[e >> 1] & 0xffff0000u) : __uint_as_float(cw[e >> 1] << 16);
            float pv = (e & 1) ? __uint_as_float(pw[e >> 1] & 0xffff0000u) : __uint_as_float(pw[e >> 1] << 16);
            float nx = (e & 1) ? __uint_as_float(nw2[e >> 1] & 0xffff0000u) : __uint_as_float(nw2[e >> 1] << 16);
            float mu = g == 0 ? mur[e] : g == 1 ? muk[e] : muv[e];
            float val = z + mu * (0.5f * (pv + nx) - z);
            if (g == 0) rr[e] = val; else if (g == 1) kk[e] = val; else vv[e] = val;
          }
        }
        uint2 su = *(const uint2*)(SW + ((size_t)d * T + t) * 512 + h * 64 + pc);
        uint2 au = *(const uint2*)(AA + ((size_t)d * T + t) * 512 + h * 64 + pc);
        unsigned sw2[2] = {su.x, su.y}, aw2[2] = {au.x, au.y};
        float kq[4], n2 = 0.f;
#pragma unroll
        for (int e = 0; e < 4; ++e) { kq[e] = kk[e] * kkw[e]; n2 += kq[e] * kq[e]; }
        n2 = row16_sum(n2);
        const float inv = 1.f / fmaxf(sqrtf(n2), 1e-12f);
        float4 o_na, o_w, o_b, o_kd, o_r;
        float tna[4], tw_[4], tb[4], tkd[4];
#pragma unroll
        for (int e = 0; e < 4; ++e) {
          float sg = (e & 1) ? __uint_as_float(sw2[e >> 1] & 0xffff0000u) : __uint_as_float(sw2[e >> 1] << 16);
          float a = (e & 1) ? __uint_as_float(aw2[e >> 1] & 0xffff0000u) : __uint_as_float(aw2[e >> 1] << 16);
          float kn = kq[e] * inv;
          tna[e] = -kn; tw_[e] = __expf(-sg); tb[e] = kn * a; tkd[e] = kk[e] * (1.f + (a - 1.f) * kaw[e]);
        }
        o_na = make_float4(tna[0], tna[1], tna[2], tna[3]); o_w = make_float4(tw_[0], tw_[1], tw_[2], tw_[3]);
        o_b = make_float4(tb[0], tb[1], tb[2], tb[3]); o_kd = make_float4(tkd[0], tkd[1], tkd[2], tkd[3]);
        o_r = make_float4(rr[0], rr[1], rr[2], rr[3]);
        *(float4*)(NA + pj * 64 + pc) = o_na; *(float4*)(Wd + pj * 64 + pc) = o_w; *(float4*)(Bv + pj * 64 + pc) = o_b;
        *(float4*)(KD + pj * 64 + pc) = o_kd; *(float4*)(Rr + pj * 64 + pc) = o_r;
        if ((pc >> 4) == rq) *(float4*)(Vv + pj * 16 + (pc & 15)) = make_float4(vv[0], vv[1], vv[2], vv[3]);
      }
      __syncthreads();
      if (w < 4) {
#pragma unroll 4
        for (int j = 0; j < 32; ++j) {
          const float4 na = *(const float4*)(NA + j * 64 + jl * 4);
          const float4 wv = *(const float4*)(Wd + j * 64 + jl * 4);
          const float4 bv = *(const float4*)(Bv + j * 64 + jl * 4);
          const float4 kd = *(const float4*)(KD + j * 64 + jl * 4);
          const float4 rv = *(const float4*)(Rr + j * 64 + jl * 4);
          const float v = Vv[j * 16 + rl];
          float pa = s0 * na.x + s1 * na.y + s2 * na.z + s3 * na.w;
          pa = row16_sum(pa);
          s0 = s0 * wv.x + (pa * bv.x + v * kd.x);
          s1 = s1 * wv.y + (pa * bv.y + v * kd.y);
          s2 = s2 * wv.z + (pa * bv.z + v * kd.z);
          s3 = s3 * wv.w + (pa * bv.w + v * kd.w);
          float py = s0 * rv.x + s1 * rv.y + s2 * rv.z + s3 * rv.w;
          py = row16_sum(py);
          if (jl == 0) YS[j * 16 + rl] = py;
        }
      }
      __syncthreads();
      {
        const int step = ci * 32 + (tid >> 4), s = d ? (S - 1 - step) : step, t = b * S + s;
        Y[((size_t)d * T + t) * 512 + h * 64 + rq * 16 + (tid & 15)] = YS[tid];
      }
    }
    __syncthreads();
  }
}

DI void p4_final(const Params& P, char* smem) {
  const int tid = threadIdx.x, c = tid;
  float* sg = (float*)smem;
  const u16* ZR = (const u16*)(P.ws + ZR_OFF);
  const u16* AA = (const u16*)P.out + (size_t)2 * T * 512;
  const float* Y = (const float*)(P.ws + Y_OFF);
  u16* RW = (u16*)(P.ws + RW_OFF);
  const float mur = P.shift_mu[c], muk = P.shift_mu[512 + c], muv = P.shift_mu[1024 + c], ka = P.k_a[c];
  const float rk0 = P.r_k[c], rk1 = P.r_k[512 + c], lw = P.lnx_w[c], lb = P.lnx_b[c];
  for (int tile = blockIdx.x; tile < T / 32; tile += gridDim.x) {
    const int t0 = tile * 32;
#pragma unroll
    for (int i = 0; i < 8; ++i) {
      int idx = i * NTHR + tid, tt = idx >> 7, col = idx & 127, t = t0 + tt, zc = 1664 + col;
      sg[col * 32 + tt] = sigmoidf(zshift(ZR, t, t & 4095, zc, P.shift_mu[zc]));
    }
    __syncthreads();
    float accg[32];
#pragma unroll
    for (int tt = 0; tt < 32; ++tt) accg[tt] = 0.f;
#pragma unroll 2
    for (int r = 0; r < 128; ++r) {
      const float gv = P.g2[r * 512 + c];
#pragma unroll
      for (int q = 0; q < 8; ++q) {
        float4 x4 = *(const float4*)(sg + r * 32 + q * 4);
        accg[q * 4 + 0] += x4.x * gv; accg[q * 4 + 1] += x4.y * gv; accg[q * 4 + 2] += x4.z * gv; accg[q * 4 + 3] += x4.w * gv;
      }
    }
#pragma unroll
    for (int tt = 0; tt < 32; ++tt) {
      const int t = t0 + tt, s = t & 4095;
      const float r = zshift(ZR, t, s, c, mur), k = zshift(ZR, t, s, 512 + c, muk), v = zshift(ZR, t, s, 1024 + c, muv);
      const float a0 = bf2f(AA[(size_t)t * 512 + c]), a1 = bf2f(AA[((size_t)T + t) * 512 + c]);
      const float kd0 = k * (1.f + (a0 - 1.f) * ka), kd1 = k * (1.f + (a1 - 1.f) * ka);
      const float bonus = wave_sum(r * (kd0 * rk0 + kd1 * rk1));
      const float y = Y[(size_t)t * 512 + c] + Y[((size_t)T + t) * 512 + c];
      const float mu = wave_sum(y) * (1.f / 64.f);
      const float dv = y - mu;
      const float var = wave_sum(dv * dv) * (1.f / 64.f);
      const float yn = dv * rsqrtf(var + 64e-5f) * lw + lb;
      RW[(size_t)t * 512 + c] = f2bf((yn + bonus * v) * accg[tt]);
    }
    __syncthreads();
  }
}

DI void p5_merge(const Params& P, char* smem) {
  const u16* AT = (const u16*)(P.ws + ATTN_OFF); const u16* RW = (const u16*)(P.ws + RW_OFF);
  const u16* WB = (const u16*)P.ws; const u16* GT = (const u16*)(P.ws + GATES_OFF);
  u16* MG = (u16*)(P.ws + MERGED_OFF);
  for (int t = blockIdx.x; t < 64 * 8; t += gridDim.x) {
    const int m0 = (t / 8) * 256, n0 = (t % 8) * 128;
    f32x4 acc[4][4]; zero_acc(acc);
    gemm_main(AT, 512, WB + WT_UA, 512, 512, m0, n0, acc, smem);
    EPI_LOOP( MG[(size_t)row * 1024 + col] = f2bf(acc[i][j][r] * bf2f(GT[(size_t)row * 2048 + col])); );
  }
  for (int t = blockIdx.x; t < 64 * 8; t += gridDim.x) {
    const int m0 = (t / 8) * 256, n0 = (t % 8) * 128;
    f32x4 acc[4][4]; zero_acc(acc);
    gemm_main(RW, 512, WB + WT_UR, 512, 512, m0, n0, acc, smem);
    EPI_LOOP( const float g1 = bf2f(GT[(size_t)row * 2048 + 1024 + col]);
              MG[(size_t)row * 1024 + col] = f2bf(bf2f(MG[(size_t)row * 1024 + col]) + g1 * acc[i][j][r]); );
  }
}
DI void p6_outproj(const Params& P, char* smem) {
  const u16* MG = (const u16*)(P.ws + MERGED_OFF); const u16* WB = (const u16*)P.ws;
  for (int t = blockIdx.x; t < 64 * 8; t += gridDim.x) {
    const int m0 = (t / 8) * 256, n0 = (t % 8) * 128;
    f32x4 acc[4][4]; zero_acc(acc);
    gemm_main(MG, 1024, WB + WT_OUT, 1024, 1024, m0, n0, acc, smem);
    EPI_LOOP( P.out[(size_t)row * 1024 + col] = P.x[(size_t)row * 1024 + col] + acc[i][j][r]; );
  }
}
DI void p8_ff1(const Params& P, char* smem) {
  const u16* HF = (const u16*)(P.ws + HF_OFF); const u16* WB = (const u16*)P.ws; u16* HID = (u16*)(P.ws + HID_OFF);
  for (int t = blockIdx.x; t < 64 * 32; t += gridDim.x) {
    const int m0 = (t / 32) * 256, n0 = (t % 32) * 128;
    f32x4 acc[4][4]; zero_acc(acc);
    gemm_main(HF, 1024, WB + WT_FF1, 1024, 1024, m0, n0, acc, smem);
    EPI_LOOP( const float a = fmaxf(acc[i][j][r], 0.f); HID[(size_t)row * 4096 + col] = f2bf(a * a); );
  }
}
DI void p9_ff2(const Params& P, char* smem) {
  const u16* HID = (const u16*)(P.ws + HID_OFF); const u16* WB = (const u16*)P.ws;
  for (int t = blockIdx.x; t < 64 * 8; t += gridDim.x) {
    const int m0 = (t / 8) * 256, n0 = (t % 8) * 128;
    f32x4 acc[4][4]; zero_acc(acc);
    gemm_main(HID, 4096, WB + WT_FF2, 4096, 4096, m0, n0, acc, smem);
    EPI_LOOP( P.out[(size_t)row * 1024 + col] += acc[i][j][r]; );
  }
}
DI void p10_cvt_p(const Params& P) {
  u16* PB = (u16*)(P.ws + PB_OFF);
  const float4* p4 = (const float4*)P.p;
  for (int e = blockIdx.x * NTHR + threadIdx.x; e < T * 256 / 4; e += gridDim.x * NTHR) {
    float4 v = p4[e]; uint2 o; o.x = pack2(v.x, v.y); o.y = pack2(v.z, v.w);
    *(uint2*)(PB + (size_t)e * 4) = o;
  }
}
DI void p11_ple(const Params& P, char* smem) {
  const u16* PB = (const u16*)(P.ws + PB_OFF); const u16* HP = (const u16*)(P.ws + HP_OFF); const u16* WB = (const u16*)P.ws;
  u16* PE = (u16*)(P.ws + PE_OFF);
  for (int t = blockIdx.x; t < 64 * 8; t += gridDim.x) {
    const int m0 = (t / 8) * 256, n0 = (t % 8) * 128;
    f32x4 acc[4][4]; zero_acc(acc);
    gemm_main(PB, 256, WB + WT_PL, 256, 256, m0, n0, acc, smem);
    EPI_LOOP( PE[(size_t)row * 1024 + col] = f2bf(acc[i][j][r]); );
  }
  for (int t = blockIdx.x; t < 64 * 8; t += gridDim.x) {
    const int m0 = (t / 8) * 256, n0 = (t % 8) * 128;
    f32x4 acc[4][4]; zero_acc(acc);
    gemm_main(HP, 1024, WB + WT_PG, 1024, 1024, m0, n0, acc, smem);
    EPI_LOOP( P.out[(size_t)row * 1024 + col] += bf2f(PE[(size_t)row * 1024 + col]) * sigmoidf(acc[i][j][r]); );
  }
}

constexpr int NPHASE = 13;
__global__ void __launch_bounds__(NTHR) mega(Params P, int ph_lo, int ph_hi) {
  extern __shared__ __attribute__((aligned(16))) char smem[];
#define PHASE(n, body) if (ph_lo <= (n) && (n) < ph_hi) { body; if ((n) + 1 < ph_hi) cg::this_grid().sync(); }
  PHASE(0, p0_prep(P, smem); rmsnorm_rows(P.x, P.norm_mix, (u16*)P.out))
  PHASE(1, p1_proj(P, smem))
  PHASE(2, p1b_qknorm(P))
  PHASE(3, p2_attn_naive(P, smem); p2_prep(P, smem))
  PHASE(4, p3_scan(P, smem))
  PHASE(5, p4_final(P, smem))
  PHASE(6, p5_merge(P, smem))
  PHASE(7, p6_outproj(P, smem))
  PHASE(8, rmsnorm_rows(P.out, P.norm_ffn, (u16*)(P.ws + HF_OFF)))
  PHASE(9, p8_ff1(P, smem))
  PHASE(10, p9_ff2(P, smem))
  PHASE(11, rmsnorm_rows(P.out, P.norm_ple, (u16*)(P.ws + HP_OFF)); p10_cvt_p(P))
  PHASE(12, p11_ple(P, smem))
#undef PHASE
}

extern "C" void kernel_launch(void* const* d_in, const int* in_sizes, int n_in, void* d_out, int out_size, void* d_ws,
                              size_t ws_size, hipStream_t stream) {
  static int grid = 0;
  if (grid == 0) {
    int dev = 0, cus = 0, per_cu = 0;
    hipGetDevice(&dev);
    hipDeviceGetAttribute(&cus, hipDeviceAttributeMultiprocessorCount, dev);
    hipFuncSetAttribute((const void*)mega, hipFuncAttributeMaxDynamicSharedMemorySize, LDS_BYTES);
    hipOccupancyMaxActiveBlocksPerMultiprocessor(&per_cu, (const void*)mega, NTHR, LDS_BYTES);
    if (per_cu < 1) per_cu = 1;
    grid = cus * per_cu;
    if (ws_size < 268435456ull) fprintf(stderr, "kernel_launch: workspace too small: %zu\n", ws_size);
    fprintf(stderr, "kernel_launch: grid %d (cus %d x %d)\n", grid, cus, per_cu);
  }
  Params P{};
  const float** pp = (const float**)&P;
  for (int i = 0; i < 27; ++i) pp[i] = (const float*)d_in[i];
  P.out = (float*)d_out; P.ws = (char*)d_ws;
#if ONE_LAUNCH
  int lo = 0, hi = NPHASE;
  void* args[] = {&P, &lo, &hi};
  hipError_t e = hipLaunchCooperativeKernel((const void*)mega, dim3(grid), dim3(NTHR), args, LDS_BYTES, stream);
  if (e != hipSuccess) fprintf(stderr, "cooperative launch failed: %s\n", hipGetErrorString(e));
#else
  for (int ph = 0; ph < NPHASE; ++ph) hipLaunchKernelGGL(mega, dim3(grid), dim3(NTHR), LDS_BYTES, stream, P, ph, ph + 1);
#endif
}
```

```cpp
#include <hip/hip_runtime.h>
#include <hip/hip_cooperative_groups.h>
#include <cstdio>
namespace cg = cooperative_groups;

#define DI __device__ __forceinline__
typedef unsigned short u16;
using bf16x8 = __attribute__((ext_vector_type(8))) short;
using f32x4 = __attribute__((ext_vector_type(4))) float;

constexpr int T = 16384, S = 4096;
constexpr int NTHR = 512;
constexpr int LDS_BYTES = 126976;
#ifndef ONE_LAUNCH
#define ONE_LAUNCH 1
#endif

constexpr size_t WT_IN = 0, WT_UA = 4718592, WT_UR = 5242880, WT_OUT = 5767168, WT_FF1 = 6815744,
                 WT_FF2 = 11010048, WT_PG = 15204352, WT_PL = 16252928;
constexpr size_t ROT_OFF = 33030144;
constexpr size_t QKV_OFF = 33554432;
constexpr size_t K_OFF = QKV_OFF + 16777216, VT_OFF = K_OFF + 4194304;
constexpr size_t ZR_OFF = 58720256;
constexpr size_t GATES_OFF = 117440512;
constexpr size_t ATTN_OFF = 184549376;
constexpr size_t Y_OFF = 201326592;
constexpr size_t RW_OFF = QKV_OFF;
constexpr size_t MERGED_OFF = ZR_OFF;
constexpr size_t HF_OFF = Y_OFF;
constexpr size_t HID_OFF = QKV_OFF;
constexpr size_t HP_OFF = Y_OFF + 33554432;
constexpr size_t PB_OFF = ATTN_OFF;
constexpr size_t PE_OFF = QKV_OFF;

struct Params {
  const float *x, *p, *norm_mix, *w_in, *shift_mu, *q_norm, *k_norm, *sink, *w0, *w2, *a0, *a2, *g2, *k_k, *k_a,
      *r_k, *lnx_w, *lnx_b, *w_up_attn, *w_up_rwkv, *w_out, *norm_ffn, *w_ff1, *w_ff2, *norm_ple, *w_ple_gate, *w_ple;
  float* out;
  char* ws;
};

DI u16 f2bf(float x) { unsigned u = __float_as_uint(x); u += 0x7fffu + ((u >> 16) & 1u); return (u16)(u >> 16); }
DI float bf2f(u16 h) { return __uint_as_float(((unsigned)h) << 16); }
DI unsigned pack2(float a, float b) { return (unsigned)f2bf(a) | ((unsigned)f2bf(b) << 16); }
DI float sigmoidf(float x) { return 1.f / (1.f + __expf(-x)); }
DI float wave_sum(float v) { for (int m = 32; m >= 1; m >>= 1) v += __shfl_xor(v, m); return v; }
DI float wave_max(float v) { for (int m = 32; m >= 1; m >>= 1) v = fmaxf(v, __shfl_xor(v, m)); return v; }
template <int CTRL> DI float dppf(float x) {
  return __int_as_float(__builtin_amdgcn_update_dpp(0, __float_as_int(x), CTRL, 0xF, 0xF, true));
}
DI float row16_sum(float v) {
  v += dppf<0xB1>(v);
  v += dppf<0x4E>(v);
  v += dppf<0x141>(v);
  v += dppf<0x140>(v);
  return v;
}
DI float zshift(const u16* ZR, int t, int s, int col, float mu) {
  float z = bf2f(ZR[(size_t)t * 1792 + col]);
  float pv = s > 0 ? bf2f(ZR[(size_t)(t - 1) * 1792 + col]) : 0.f;
  float nx = s < S - 1 ? bf2f(ZR[(size_t)(t + 1) * 1792 + col]) : 0.f;
  return z + mu * (0.5f * (pv + nx) - z);
}

DI void p0_prep(const Params& P, char* smem) {
  const int tid = threadIdx.x;
  float* tile = (float*)smem;
  u16* WB = (u16*)P.ws;
  for (int t = blockIdx.x; t < 4032; t += gridDim.x) {
    const float* src; u16* dst; int K, N, lt;
    if (t < 1152) { src = P.w_in; dst = WB + WT_IN; K = 1024; N = 4608; lt = t; }
    else if (t < 1280) { src = P.w_up_attn; dst = WB + WT_UA; K = 512; N = 1024; lt = t - 1152; }
    else if (t < 1408) { src = P.w_up_rwkv; dst = WB + WT_UR; K = 512; N = 1024; lt = t - 1280; }
    else if (t < 1664) { src = P.w_out; dst = WB + WT_OUT; K = 1024; N = 1024; lt = t - 1408; }
    else if (t < 2688) { src = P.w_ff1; dst = WB + WT_FF1; K = 1024; N = 4096; lt = t - 1664; }
    else if (t < 3712) { src = P.w_ff2; dst = WB + WT_FF2; K = 4096; N = 1024; lt = t - 2688; }
    else if (t < 3968) { src = P.w_ple_gate; dst = WB + WT_PG; K = 1024; N = 1024; lt = t - 3712; }
    else { src = P.w_ple; dst = WB + WT_PL; K = 256; N = 1024; lt = t - 3968; }
    const int ntn = N >> 6, k0 = (lt / ntn) * 64, n0 = (lt % ntn) * 64;
#pragma unroll
    for (int i = 0; i < 8; ++i) { int idx = i * NTHR + tid, r = idx >> 6, c = idx & 63; tile[r * 65 + c] = src[(size_t)(k0 + r) * N + n0 + c]; }
    __syncthreads();
#pragma unroll
    for (int i = 0; i < 8; ++i) { int idx = i * NTHR + tid, n = idx >> 6, k = idx & 63; dst[(size_t)(n0 + n) * K + k0 + k] = f2bf(tile[k * 65 + n]); }
    __syncthreads();
  }
  float* ROT = (float*)(P.ws + ROT_OFF);
  for (int e = blockIdx.x * NTHR + tid; e < 32768; e += gridDim.x * NTHR) {
    int pos = e >> 3, i = e & 7;
    float invf = i == 0 ? 1.0f : i == 1 ? 0.19392274f : i == 2 ? 0.03760603f : i == 3 ? 0.0072926646f
               : i == 4 ? 0.0014142136f : i == 5 ? 0.0002742482f : i == 6 ? 5.3182957e-05f : 1.0313385e-05f;
    float ang = (float)pos * invf;
    double a = (double)ang;
    double kq = rint(a * 0.15915494309189535);
    float rf = (float)(a - kq * 6.283185307179586476925);
    ROT[e] = cosf(rf); ROT[32768 + e] = sinf(rf);
  }
}

DI void rmsnorm_rows(const float* src, const float* gain, u16* dst) {
  const int tid = threadIdx.x, lane = tid & 63;
  for (int row = blockIdx.x * 8 + (tid >> 6); row < T; row += gridDim.x * 8) {
    const float4* s4 = (const float4*)(src + (size_t)row * 1024);
    float4 v[4]; float ss = 0.f;
#pragma unroll
    for (int i = 0; i < 4; ++i) { v[i] = s4[lane + i * 64]; ss += v[i].x * v[i].x + v[i].y * v[i].y + v[i].z * v[i].z + v[i].w * v[i].w; }
    ss = wave_sum(ss);
    float sc = rsqrtf(ss * (1.f / 1024.f) + 1e-6f);
#pragma unroll
    for (int i = 0; i < 4; ++i) {
      float4 g = ((const float4*)gain)[lane + i * 64];
      uint2 o; o.x = pack2(v[i].x * sc * g.x, v[i].y * sc * g.y); o.y = pack2(v[i].z * sc * g.z, v[i].w * sc * g.w);
      *(uint2*)(dst + (size_t)row * 1024 + (lane + i * 64) * 4) = o;
    }
  }
}

#define MFMA16(a, b, c) __builtin_amdgcn_mfma_f32_16x16x32_bf16((a), (b), (c), 0, 0, 0)
constexpr int LDT = 72;
DI void gemm_main(const u16* __restrict__ A, int lda, const u16* __restrict__ Bt, int ldb, int K, int m0, int n0,
                  f32x4 (&acc)[4][4], char* smem) {
  const int tid = threadIdx.x, lane = tid & 63, w = tid >> 6, wm = w >> 1, wn = w & 1;
  u16* As = (u16*)smem;
  u16* Bs = As + 2 * 256 * LDT;
  const int nk = K >> 6;
  const int lrow = tid >> 3, lkc = (tid & 7) * 8;
  const u16* Ag = A + (size_t)(m0 + lrow) * lda + lkc;
  const u16* Bg = Bt + (size_t)(n0 + lrow) * ldb + lkc;
  uint4 ra[4], rb[2];
#define GLOAD(kt) do { \
    _Pragma("unroll") for (int i = 0; i < 4; ++i) ra[i] = *(const uint4*)(Ag + (size_t)(i * 64) * lda + (kt) * 64); \
    _Pragma("unroll") for (int i = 0; i < 2; ++i) rb[i] = *(const uint4*)(Bg + (size_t)(i * 64) * ldb + (kt) * 64); } while (0)
#define SSTORE(buf) do { \
    _Pragma("unroll") for (int i = 0; i < 4; ++i) *(uint4*)(As + (buf) * 256 * LDT + (lrow + i * 64) * LDT + lkc) = ra[i]; \
    _Pragma("unroll") for (int i = 0; i < 2; ++i) *(uint4*)(Bs + (buf) * 128 * LDT + (lrow + i * 64) * LDT + lkc) = rb[i]; } while (0)
  GLOAD(0); SSTORE(0);
  __syncthreads();
  const int fr = lane & 15, fq = (lane >> 4) * 8;
  for (int kt = 0; kt < nk; ++kt) {
    const int buf = kt & 1;
    if (kt + 1 < nk) GLOAD(kt + 1);
    const u16* Asb = As + buf * 256 * LDT + (wm * 64 + fr) * LDT + fq;
    const u16* Bsb = Bs + buf * 128 * LDT + (wn * 64 + fr) * LDT + fq;
#pragma unroll
    for (int ks = 0; ks < 2; ++ks) {
      bf16x8 af[4], bfr[4];
#pragma unroll
      for (int i = 0; i < 4; ++i) af[i] = *(const bf16x8*)(Asb + i * 16 * LDT + ks * 32);
#pragma unroll
      for (int j = 0; j < 4; ++j) bfr[j] = *(const bf16x8*)(Bsb + j * 16 * LDT + ks * 32);
#pragma unroll
      for (int i = 0; i < 4; ++i)
#pragma unroll
        for (int j = 0; j < 4; ++j) acc[i][j] = MFMA16(af[i], bfr[j], acc[i][j]);
    }
    if (kt + 1 < nk) SSTORE(buf ^ 1);
    __syncthreads();
  }
#undef GLOAD
#undef SSTORE
}
DI void zero_acc(f32x4 (&acc)[4][4]) {
#pragma unroll
  for (int i = 0; i < 4; ++i)
#pragma unroll
    for (int j = 0; j < 4; ++j) acc[i][j] = f32x4{0.f, 0.f, 0.f, 0.f};
}
#define EPI_LOOP(BODY) do { const int lane_ = threadIdx.x & 63, w_ = threadIdx.x >> 6; \
    const int rb_ = m0 + (w_ >> 1) * 64 + (lane_ >> 4) * 4, cb_ = n0 + (w_ & 1) * 64 + (lane_ & 15); \
    _Pragma("unroll") for (int i = 0; i < 4; ++i) { _Pragma("unroll") for (int j = 0; j < 4; ++j) { \
      _Pragma("unroll") for (int r = 0; r < 4; ++r) { const int row = rb_ + i * 16 + r, col = cb_ + j * 16; BODY } } \
      __builtin_amdgcn_sched_barrier(0); } } while (0)

DI void p1_proj(const Params& P, char* smem) {
  const u16* H = (const u16*)P.out;
  const u16* Wt = (const u16*)P.ws + WT_IN;
  u16* Q = (u16*)(P.ws + QKV_OFF); u16* Kb = (u16*)(P.ws + K_OFF); u16* VT = (u16*)(P.ws + VT_OFF);
  u16* ZR = (u16*)(P.ws + ZR_OFF); u16* GT = (u16*)(P.ws + GATES_OFF);
  for (int t = blockIdx.x; t < 64 * 36; t += gridDim.x) {
    const int m0 = (t / 36) * 256, n0 = (t % 36) * 128;
    f32x4 acc[4][4]; zero_acc(acc);
    gemm_main(H, 1024, Wt, 1024, 1024, m0, n0, acc, smem);
    if (n0 < 512) { EPI_LOOP( Q[(size_t)row * 512 + col] = f2bf(acc[i][j][r]); ); }
    else if (n0 == 512) { EPI_LOOP( Kb[(size_t)row * 128 + (col - 512)] = f2bf(acc[i][j][r]); ); }
    else if (n0 == 640) {
      const int lane = threadIdx.x & 63, w = threadIdx.x >> 6;
      const int rb = m0 + (w >> 1) * 64 + (lane >> 4) * 4, cb = (w & 1) * 64 + (lane & 15);
#pragma unroll
      for (int i = 0; i < 4; ++i)
#pragma unroll
        for (int j = 0; j < 4; ++j) {
          const int row = rb + i * 16, c = cb + j * 16;
          const int b = row >> 12, s = row & 4095, kvh = c >> 6, d = c & 63;
          uint2 o; o.x = pack2(acc[i][j][0], acc[i][j][1]); o.y = pack2(acc[i][j][2], acc[i][j][3]);
          *(uint2*)(VT + ((size_t)((b * 2 + kvh) * 64 + d)) * 4096 + s) = o;
        }
    }
    else if (n0 < 2560) { EPI_LOOP( ZR[(size_t)row * 1792 + (col - 768)] = f2bf(acc[i][j][r]); ); }
    else { EPI_LOOP( GT[(size_t)row * 2048 + (col - 2560)] = f2bf(sigmoidf(acc[i][j][r])); ); }
  }
}

DI void norm_row_to_lds(const u16* srow, bool valid, const float* gain, const float* ROT, int pos, float scale, u16* drow, int quarter) {
  uint4 o0 = make_uint4(0u, 0u, 0u, 0u), o1 = o0;
  uint4 a0 = o0, a1 = o0;
  if (valid) { a0 = *(const uint4*)(srow + quarter * 16); a1 = *(const uint4*)(srow + quarter * 16 + 8); }
  unsigned uu[8] = {a0.x, a0.y, a0.z, a0.w, a1.x, a1.y, a1.z, a1.w};
  float x[16]; float ss = 0.f;
#pragma unroll
  for (int e = 0; e < 8; ++e) { x[2 * e] = __uint_as_float(uu[e] << 16); x[2 * e + 1] = __uint_as_float(uu[e] & 0xffff0000u); ss += x[2 * e] * x[2 * e] + x[2 * e + 1] * x[2 * e + 1]; }
  ss += __shfl_xor(ss, 1); ss += __shfl_xor(ss, 2);
  const float sc = rsqrtf(ss * (1.f / 64.f) + 1e-6f);
  const float4* g4 = (const float4*)(gain + quarter * 16);
#pragma unroll
  for (int e = 0; e < 4; ++e) { float4 g = g4[e]; x[4 * e] *= sc * g.x; x[4 * e + 1] *= sc * g.y; x[4 * e + 2] *= sc * g.z; x[4 * e + 3] *= sc * g.w; }
  if (quarter == 0 && valid) {
    const float4* c4 = (const float4*)(ROT + pos * 8); const float4* s4 = (const float4*)(ROT + 32768 + pos * 8);
    float4 ca = c4[0], cb = c4[1], sa = s4[0], sb = s4[1];
    float cs[8] = {ca.x, ca.y, ca.z, ca.w, cb.x, cb.y, cb.z, cb.w}, sn[8] = {sa.x, sa.y, sa.z, sa.w, sb.x, sb.y, sb.z, sb.w};
#pragma unroll
    for (int e = 0; e < 8; ++e) { float x1 = x[e], x2 = x[e + 8]; x[e] = x1 * cs[e] - x2 * sn[e]; x[e + 8] = x2 * cs[e] + x1 * sn[e]; }
  }
  if (valid) {
    o0 = make_uint4(pack2(x[0] * scale, x[1] * scale), pack2(x[2] * scale, x[3] * scale), pack2(x[4] * scale, x[5] * scale), pack2(x[6] * scale, x[7] * scale));
    o1 = make_uint4(pack2(x[8] * scale, x[9] * scale), pack2(x[10] * scale, x[11] * scale), pack2(x[12] * scale, x[13] * scale), pack2(x[14] * scale, x[15] * scale));
  }
  *(uint4*)(drow + quarter * 16) = o0; *(uint4*)(drow + quarter * 16 + 8) = o1;
}

constexpr int VTS = 392;
DI void p2_attn(const Params& P, char* smem) {
  const int tid = threadIdx.x, lane = tid & 63, w = tid >> 6;
  u16* Ks = (u16*)smem;
  u16* Vt = Ks + 384 * LDT;
  u16* Qs = Vt + 64 * VTS;
  const u16* Q = (const u16*)(P.ws + QKV_OFF); const u16* Kb = (const u16*)(P.ws + K_OFF); const u16* VT = (const u16*)(P.ws + VT_OFF);
  const float* ROT = (const float*)(P.ws + ROT_OFF);
  u16* AT = (u16*)(P.ws + ATTN_OFF);
  const int fr = lane & 15, fg = lane >> 4;
  for (int bi = blockIdx.x; bi < 256; bi += gridDim.x) {
    const int kvh = bi & 1, qblk = (bi >> 1) & 31, b = bi >> 6;
    const int kbase = qblk * 128 - 128;
#pragma unroll 1
    for (int ps = 0; ps < 3; ++ps) {
      const int rowl = ps * 128 + (tid >> 2), kp = kbase + rowl;
      const bool valid = kp >= 0 && kp < S;
      norm_row_to_lds(Kb + (size_t)(b * S + (valid ? kp : 0)) * 128 + kvh * 64, valid, P.k_norm, ROT, kp, 1.0f, Ks + rowl * LDT, tid & 3);
    }
#pragma unroll 2
    for (int i = 0; i < 6; ++i) {
      const int c = i * NTHR + tid, d = c / 48, kc = c % 48, kp = kbase + kc * 8;
      uint4 v = make_uint4(0u, 0u, 0u, 0u);
      if (kp >= 0 && kp < S) v = *(const uint4*)(VT + ((size_t)((b * 2 + kvh) * 64 + d)) * 4096 + kp);
      *(uint4*)(Vt + d * VTS + kc * 8) = v;
    }
#pragma unroll 1
    for (int g = 0; g < 4; ++g) {
      const int qh = kvh * 4 + g;
      {
        const int rowl = tid >> 2, qp = qblk * 128 + rowl;
        norm_row_to_lds(Q + (size_t)(b * S + qp) * 512 + qh * 64, true, P.q_norm, ROT, qp, 0.125f * 1.44269504f, Qs + rowl * LDT, tid & 3);
      }
      __syncthreads();
      const int qw = w * 16;
      bf16x8 bq0 = *(const bf16x8*)(Qs + (qw + fr) * LDT + fg * 8);
      bf16x8 bq1 = *(const bf16x8*)(Qs + (qw + fr) * LDT + 32 + fg * 8);
      f32x4 st[17];
#pragma unroll
      for (int i = 0; i < 17; ++i) {
        const bf16x8 ak0 = *(const bf16x8*)(Ks + ((w + i) * 16 + fr) * LDT + fg * 8);
        const bf16x8 ak1 = *(const bf16x8*)(Ks + ((w + i) * 16 + fr) * LDT + 32 + fg * 8);
        f32x4 z = {0.f, 0.f, 0.f, 0.f};
        z = MFMA16(ak0, bq0, z);
        st[i] = MFMA16(ak1, bq1, z);
        if ((i & 3) == 3) __builtin_amdgcn_sched_barrier(0);
      }
#pragma unroll
      for (int r = 0; r < 4; ++r) {
        st[0][r] = (fg * 4 + r >= fr) ? st[0][r] : -1e30f;
        st[16][r] = (fg * 4 + r <= fr) ? st[16][r] : -1e30f;
      }
      if (qblk == 0 || qblk == 31) {
#pragma unroll
        for (int i = 0; i < 17; ++i) {
          const int kt = w + i;
          const float pen = ((qblk == 0 && kt < 8) || (qblk == 31 && kt >= 16)) ? -1e30f : 0.f;
#pragma unroll
          for (int r = 0; r < 4; ++r) st[i][r] += pen;
        }
      }
      float m = -1e30f;
#pragma unroll
      for (int i = 0; i < 17; ++i)
#pragma unroll
        for (int r = 0; r < 4; ++r) m = fmaxf(m, st[i][r]);
      m = fmaxf(m, __shfl_xor(m, 16)); m = fmaxf(m, __shfl_xor(m, 32));
      const float sk = P.sink[qh] * 1.44269504f;
      m = fmaxf(m, sk);
      float l = 0.f;
#pragma unroll
      for (int i = 0; i < 17; ++i)
#pragma unroll
        for (int r = 0; r < 4; ++r) {
          const float pv = __builtin_amdgcn_exp2f(st[i][r] - m);
          st[i][r] = pv; l += pv;
        }
      l += __shfl_xor(l, 16); l += __shfl_xor(l, 32);
      l += __builtin_amdgcn_exp2f(sk - m);
      const float invl = 1.f / l;
      f32x4 ot[4];
#pragma unroll
      for (int dt = 0; dt < 4; ++dt) ot[dt] = f32x4{0.f, 0.f, 0.f, 0.f};
#pragma unroll
      for (int c = 0; c < 9; ++c) {
        union { unsigned u[4]; bf16x8 v; } pb;
        pb.u[0] = pack2(st[2 * c][0], st[2 * c][1]); pb.u[1] = pack2(st[2 * c][2], st[2 * c][3]);
        if (c < 8) { pb.u[2] = pack2(st[2 * c + 1][0], st[2 * c + 1][1]); pb.u[3] = pack2(st[2 * c + 1][2], st[2 * c + 1][3]); }
        else { pb.u[2] = 0u; pb.u[3] = 0u; }
        const int k0 = (w + 2 * c) * 16 + fg * 4, k1 = min(w + 2 * c + 1, 23) * 16 + fg * 4;
#pragma unroll
        for (int dt = 0; dt < 4; ++dt) {
          union { uint2 h[2]; bf16x8 v; } av;
          av.h[0] = *(const uint2*)(Vt + (dt * 16 + fr) * VTS + k0);
          av.h[1] = *(const uint2*)(Vt + (dt * 16 + fr) * VTS + k1);
          ot[dt] = MFMA16(av.v, pb.v, ot[dt]);
        }
        __builtin_amdgcn_sched_barrier(0);
      }
      const size_t tok = (size_t)(b * S + qblk * 128 + qw + fr);
#pragma unroll
      for (int dt = 0; dt < 4; ++dt) {
        uint2 o; o.x = pack2(ot[dt][0] * invl, ot[dt][1] * invl); o.y = pack2(ot[dt][2] * invl, ot[dt][3] * invl);
        *(uint2*)(AT + tok * 512 + qh * 64 + dt * 16 + fg * 4) = o;
      }
      __syncthreads();
    }
  }
}

DI void p2_prep(const Params& P, char* smem) {
  const int tid = threadIdx.x, c = tid;
  float* tw = (float*)smem;
  float* al = tw + 64 * 32;
  const u16* ZR = (const u16*)(P.ws + ZR_OFF);
  u16* SW = (u16*)P.out; u16* AA = SW + (size_t)2 * T * 512;
  for (int tile = blockIdx.x; tile < T / 32; tile += gridDim.x) {
    const int t0 = tile * 32;
#pragma unroll
    for (int i = 0; i < 8; ++i) {
      int idx = i * NTHR + tid, tt = idx >> 7, col = idx & 127, t = t0 + tt, zc = 1536 + col;
      float z = zshift(ZR, t, t & 4095, zc, P.shift_mu[zc]);
      if (col < 64) tw[col * 32 + tt] = tanhf(z); else al[(col - 64) * 32 + tt] = z;
    }
    __syncthreads();
#pragma unroll 1
    for (int d = 0; d < 2; ++d) {
      float accw[32], acca[32];
#pragma unroll
      for (int tt = 0; tt < 32; ++tt) { accw[tt] = 0.f; acca[tt] = 0.f; }
      const float* w2p = P.w2 + (size_t)d * 64 * 512 + c;
      const float* a2p = P.a2 + (size_t)d * 64 * 512 + c;
#pragma unroll 2
      for (int r = 0; r < 64; ++r) {
        const float wv = w2p[r * 512], av = a2p[r * 512];
#pragma unroll
        for (int q = 0; q < 8; ++q) {
          float4 x4 = *(const float4*)(tw + r * 32 + q * 4), y4 = *(const float4*)(al + r * 32 + q * 4);
          accw[q * 4 + 0] += x4.x * wv; accw[q * 4 + 1] += x4.y * wv; accw[q * 4 + 2] += x4.z * wv; accw[q * 4 + 3] += x4.w * wv;
          acca[q * 4 + 0] += y4.x * av; acca[q * 4 + 1] += y4.y * av; acca[q * 4 + 2] += y4.z * av; acca[q * 4 + 3] += y4.w * av;
        }
      }
      const float w0v = P.w0[d * 512 + c], a0v = P.a0[d * 512 + c];
#pragma unroll
      for (int tt = 0; tt < 32; ++tt) {
        SW[((size_t)d * T + t0 + tt) * 512 + c] = f2bf(0.60653066f * sigmoidf(w0v + accw[tt]));
        AA[((size_t)d * T + t0 + tt) * 512 + c] = f2bf(sigmoidf(a0v + acca[tt]));
      }
    }
    __syncthreads();
  }
}

constexpr int SCB = 5 * 2048 + 512 + 512;
DI void scan_prep_task(const u16* ZR, const u16* SW, const u16* AA, float* buf, int d, int b, int h, int rq, int ci, int pj, int pc,
                       const float (&mur)[4], const float (&muk)[4], const float (&muv)[4], const float (&kkw)[4], const float (&kaw)[4]) {
  const int step = ci * 32 + pj, s = d ? (S - 1 - step) : step, t = b * S + s;
  const u16* zp = ZR + (size_t)t * 1792 + h * 64 + pc;
  float rr[4], kk[4], vv[4];
#pragma unroll
  for (int g = 0; g < 3; ++g) {
    uint2 cu = *(const uint2*)(zp + g * 512);
    uint2 pu = s > 0 ? *(const uint2*)(zp + g * 512 - 1792) : make_uint2(0u, 0u);
    uint2 nu = s < S - 1 ? *(const uint2*)(zp + g * 512 + 1792) : make_uint2(0u, 0u);
    unsigned cw[2] = {cu.x, cu.y}, pw[2] = {pu.x, pu.y}, nw2[2] = {nu.x, nu.y};
#pragma unroll
    for (int e = 0; e < 4; ++e) {
      float z = (e & 1) ? __uint_as_float(cw[e >> 1] & 0xffff0000u) : __uint_as_float(cw[e >> 1] << 16);
      float pv = (e & 1) ? __uint_as_float(pw[e >> 1] & 0xffff0000u) : __uint_as_float(pw[e >> 1] << 16);
      float nx = (e & 1) ? __uint_as_float(nw2[e >> 1] & 0xffff0000u) : __uint_as_float(nw2[e >> 1] << 16);
      float mu = g == 0 ? mur[e] : g == 1 ? muk[e] : muv[e];
      float val = z + mu * (0.5f * (pv + nx) - z);
      if (g == 0) rr[e] = val; else if (g == 1) kk[e] = val; else vv[e] = val;
    }
  }
  uint2 su = *(const uint2*)(SW + ((size_t)d * T + t) * 512 + h * 64 + pc);
  uint2 au = *(const uint2*)(AA + ((size_t)d * T + t) * 512 + h * 64 + pc);
  unsigned sw2[2] = {su.x, su.y}, aw2[2] = {au.x, au.y};
  float kq[4], n2 = 0.f;
#pragma unroll
  for (int e = 0; e < 4; ++e) { kq[e] = kk[e] * kkw[e]; n2 += kq[e] * kq[e]; }
  n2 = row16_sum(n2);
  const float inv = 1.f / fmaxf(sqrtf(n2), 1e-12f);
  float tna[4], tw_[4], tb[4], tkd[4];
#pragma unroll
  for (int e = 0; e < 4; ++e) {
    float sg = (e & 1) ? __uint_as_float(sw2[e >> 1] & 0xffff0000u) : __uint_as_float(sw2[e >> 1] << 16);
    float a = (e & 1) ? __uint_as_float(aw2[e >> 1] & 0xffff0000u) : __uint_as_float(aw2[e >> 1] << 16);
    float kn = kq[e] * inv;
    tna[e] = -kn; tw_[e] = __expf(-sg); tb[e] = kn * a; tkd[e] = kk[e] * (1.f + (a - 1.f) * kaw[e]);
  }
  float* NA = buf; float* Wd = NA + 2048; float* Bv = Wd + 2048; float* KD = Bv + 2048; float* Rr = KD + 2048; float* Vv = Rr + 2048;
  *(float4*)(NA + pj * 64 + pc) = make_float4(tna[0], tna[1], tna[2], tna[3]);
  *(float4*)(Wd + pj * 64 + pc) = make_float4(tw_[0], tw_[1], tw_[2], tw_[3]);
  *(float4*)(Bv + pj * 64 + pc) = make_float4(tb[0], tb[1], tb[2], tb[3]);
  *(float4*)(KD + pj * 64 + pc) = make_float4(tkd[0], tkd[1], tkd[2], tkd[3]);
  *(float4*)(Rr + pj * 64 + pc) = make_float4(rr[0], rr[1], rr[2], rr[3]);
  if ((pc >> 4) == rq) *(float4*)(Vv + pj * 16 + (pc & 15)) = make_float4(vv[0], vv[1], vv[2], vv[3]);
}
DI void p3_scan(const Params& P, char* smem) {
  const int tid = threadIdx.x, lane = tid & 63, w = tid >> 6;
  float* bufs = (float*)smem;
  const u16* ZR = (const u16*)(P.ws + ZR_OFF);
  const u16* SW = (const u16*)P.out; const u16* AA = SW + (size_t)2 * T * 512;
  float* Y = (float*)(P.ws + Y_OFF);
  for (int item = blockIdx.x; item < 256; item += gridDim.x) {
    const int u = (item & 7) * 8 + (item >> 5), rq = (item >> 3) & 3;
    const int d = u >> 5, b = (u >> 3) & 3, h = u & 7;
    const int lt = tid & 255;
    const int pj = lt >> 4, pc = (lt & 15) * 4;
    float mur[4], muk[4], muv[4], kkw[4], kaw[4];
#pragma unroll
    for (int e = 0; e < 4; ++e) {
      mur[e] = P.shift_mu[h * 64 + pc + e]; muk[e] = P.shift_mu[512 + h * 64 + pc + e]; muv[e] = P.shift_mu[1024 + h * 64 + pc + e];
      kkw[e] = P.k_k[h * 64 + pc + e]; kaw[e] = P.k_a[h * 64 + pc + e];
    }
    float s0 = 0.f, s1 = 0.f, s2 = 0.f, s3 = 0.f;
    const int rl = (w & 3) * 4 + (lane >> 4), jl = lane & 15;
    if (w >= 4) {
      scan_prep_task(ZR, SW, AA, bufs, d, b, h, rq, 0, pj, pc, mur, muk, muv, kkw, kaw);
      scan_prep_task(ZR, SW, AA, bufs, d, b, h, rq, 0, pj + 16, pc, mur, muk, muv, kkw, kaw);
    }
    __syncthreads();
    for (int ci = 0; ci < 128; ++ci) {
      float* cur = bufs + (ci & 1) * SCB;
      if (w < 4) {
        const float* NA = cur; const float* Wd = NA + 2048; const float* Bv = Wd + 2048; const float* KD = Bv + 2048; const float* Rr = KD + 2048;
        const float* Vv = Rr + 2048; float* YS = cur + 5 * 2048 + 512;
#pragma unroll 4
        for (int j = 0; j < 32; ++j) {
          const float4 na = *(const float4*)(NA + j * 64 + jl * 4);
          const float4 wv = *(const float4*)(Wd + j * 64 + jl * 4);
          const float4 bv = *(const float4*)(Bv + j * 64 + jl * 4);
          const float4 kd = *(const float4*)(KD + j * 64 + jl * 4);
          const float4 rv = *(const float4*)(Rr + j * 64 + jl * 4);
          const float v = Vv[j * 16 + rl];
          float pa = s0 * na.x + s1 * na.y + s2 * na.z + s3 * na.w;
          pa = row16_sum(pa);
          s0 = s0 * wv.x + (pa * bv.x + v * kd.x);
          s1 = s1 * wv.y + (pa * bv.y + v * kd.y);
          s2 = s2 * wv.z + (pa * bv.z + v * kd.z);
          s3 = s3 * wv.w + (pa * bv.w + v * kd.w);
          float py = s0 * rv.x + s1 * rv.y + s2 * rv.z + s3 * rv.w;
          py = row16_sum(py);
          if (jl == 0) YS[j * 16 + rl] = py;
        }
      } else {
        if (ci > 0) {
          const float* YSp = bufs + ((ci - 1) & 1) * SCB + 5 * 2048 + 512;
#pragma unroll
          for (int q = 0; q < 2; ++q) {
            const int e = lt + q * 256, step = (ci - 1) * 32 + (e >> 4), s = d ? (S - 1 - step) : step, t = b * S + s;
            Y[((size_t)d * T + t) * 512 + h * 64 + rq * 16 + (e & 15)] = YSp[e];
          }
        }
        if (ci + 1 < 128) {
          float* nxt = bufs + ((ci + 1) & 1) * SCB;
          scan_prep_task(ZR, SW, AA, nxt, d, b, h, rq, ci + 1, pj, pc, mur, muk, muv, kkw, kaw);
          scan_prep_task(ZR, SW, AA, nxt, d, b, h, rq, ci + 1, pj + 16, pc, mur, muk, muv, kkw, kaw);
        }
      }
      __syncthreads();
    }
    if (w >= 4) {
      const float* YSp = bufs + (127 & 1) * SCB + 5 * 2048 + 512;
#pragma unroll
      for (int q = 0; q < 2; ++q) {
        const int e = lt + q * 256, step = 127 * 32 + (e >> 4), s = d ? (S - 1 - step) : step, t = b * S + s;
        Y[((size_t)d * T + t) * 512 + h * 64 + rq * 16 + (e & 15)] = YSp[e];
      }
    }
    __syncthreads();
  }
}

DI void p4_final(const Params& P, char* smem) {
  const int tid = threadIdx.x, c = tid;
  float* sg = (float*)smem;
  const u16* ZR = (const u16*)(P.ws + ZR_OFF);
  const u16* AA = (const u16*)P.out + (size_t)2 * T * 512;
  const float* Y = (const float*)(P.ws + Y_OFF);
  u16* RW = (u16*)(P.ws + RW_OFF);
  const float mur = P.shift_mu[c], muk = P.shift_mu[512 + c], muv = P.shift_mu[1024 + c], ka = P.k_a[c];
  const float rk0 = P.r_k[c], rk1 = P.r_k[512 + c], lw = P.lnx_w[c], lb = P.lnx_b[c];
  for (int tile = blockIdx.x; tile < T / 32; tile += gridDim.x) {
    const int t0 = tile * 32;
#pragma unroll
    for (int i = 0; i < 8; ++i) {
      int idx = i * NTHR + tid, tt = idx >> 7, col = idx & 127, t = t0 + tt, zc = 1664 + col;
      sg[col * 32 + tt] = sigmoidf(zshift(ZR, t, t & 4095, zc, P.shift_mu[zc]));
    }
    __syncthreads();
    float accg[32];
#pragma unroll
    for (int tt = 0; tt < 32; ++tt) accg[tt] = 0.f;
#pragma unroll 2
    for (int r = 0; r < 128; ++r) {
      const float gv = P.g2[r * 512 + c];
#pragma unroll
      for (int q = 0; q < 8; ++q) {
        float4 x4 = *(const float4*)(sg + r * 32 + q * 4);
        accg[q * 4 + 0] += x4.x * gv; accg[q * 4 + 1] += x4.y * gv; accg[q * 4 + 2] += x4.z * gv; accg[q * 4 + 3] += x4.w * gv;
      }
    }
#pragma unroll
    for (int tt = 0; tt < 32; ++tt) {
      const int t = t0 + tt, s = t & 4095;
      const float r = zshift(ZR, t, s, c, mur), k = zshift(ZR, t, s, 512 + c, muk), v = zshift(ZR, t, s, 1024 + c, muv);
      const float a0 = bf2f(AA[(size_t)t * 512 + c]), a1 = bf2f(AA[((size_t)T + t) * 512 + c]);
      const float kd0 = k * (1.f + (a0 - 1.f) * ka), kd1 = k * (1.f + (a1 - 1.f) * ka);
      const float bonus = wave_sum(r * (kd0 * rk0 + kd1 * rk1));
      const float y = Y[(size_t)t * 512 + c] + Y[((size_t)T + t) * 512 + c];
      const float mu = wave_sum(y) * (1.f / 64.f);
      const float dv = y - mu;
      const float var = wave_sum(dv * dv) * (1.f / 64.f);
      const float yn = dv * rsqrtf(var + 64e-5f) * lw + lb;
      RW[(size_t)t * 512 + c] = f2bf((yn + bonus * v) * accg[tt]);
    }
    __syncthreads();
  }
}

DI void p5_merge(const Params& P, char* smem) {
  const u16* AT = (const u16*)(P.ws + ATTN_OFF); const u16* RW = (const u16*)(P.ws + RW_OFF);
  const u16* WB = (const u16*)P.ws; const u16* GT = (const u16*)(P.ws + GATES_OFF);
  u16* MG = (u16*)(P.ws + MERGED_OFF);
  for (int t = blockIdx.x; t < 64 * 8; t += gridDim.x) {
    const int m0 = (t / 8) * 256, n0 = (t % 8) * 128;
    f32x4 acc[4][4]; zero_acc(acc);
    gemm_main(AT, 512, WB + WT_UA, 512, 512, m0, n0, acc, smem);
    EPI_LOOP( MG[(size_t)row * 1024 + col] = f2bf(acc[i][j][r] * bf2f(GT[(size_t)row * 2048 + col])); );
  }
  for (int t = blockIdx.x; t < 64 * 8; t += gridDim.x) {
    const int m0 = (t / 8) * 256, n0 = (t % 8) * 128;
    f32x4 acc[4][4]; zero_acc(acc);
    gemm_main(RW, 512, WB + WT_UR, 512, 512, m0, n0, acc, smem);
    EPI_LOOP( const float g1 = bf2f(GT[(size_t)row * 2048 + 1024 + col]);
              MG[(size_t)row * 1024 + col] = f2bf(bf2f(MG[(size_t)row * 1024 + col]) + g1 * acc[i][j][r]); );
  }
}
DI void p6_outproj(const Params& P, char* smem) {
  const u16* MG = (const u16*)(P.ws + MERGED_OFF); const u16* WB = (const u16*)P.ws;
  for (int t = blockIdx.x; t < 64 * 8; t += gridDim.x) {
    const int m0 = (t / 8) * 256, n0 = (t % 8) * 128;
    f32x4 acc[4][4]; zero_acc(acc);
    gemm_main(MG, 1024, WB + WT_OUT, 1024, 1024, m0, n0, acc, smem);
    EPI_LOOP( P.out[(size_t)row * 1024 + col] = P.x[(size_t)row * 1024 + col] + acc[i][j][r]; );
  }
}
DI void p8_ff1(const Params& P, char* smem) {
  const u16* HF = (const u16*)(P.ws + HF_OFF); const u16* WB = (const u16*)P.ws; u16* HID = (u16*)(P.ws + HID_OFF);
  for (int t = blockIdx.x; t < 64 * 32; t += gridDim.x) {
    const int m0 = (t / 32) * 256, n0 = (t % 32) * 128;
    f32x4 acc[4][4]; zero_acc(acc);
    gemm_main(HF, 1024, WB + WT_FF1, 1024, 1024, m0, n0, acc, smem);
    EPI_LOOP( const float a = fmaxf(acc[i][j][r], 0.f); HID[(size_t)row * 4096 + col] = f2bf(a * a); );
  }
}
DI void p9_ff2(const Params& P, char* smem) {
  const u16* HID = (const u16*)(P.ws + HID_OFF); const u16* WB = (const u16*)P.ws;
  for (int t = blockIdx.x; t < 64 * 8; t += gridDim.x) {
    const int m0 = (t / 8) * 256, n0 = (t % 8) * 128;
    f32x4 acc[4][4]; zero_acc(acc);
    gemm_main(HID, 4096, WB + WT_FF2, 4096, 4096, m0, n0, acc, smem);
    EPI_LOOP( P.out[(size_t)row * 1024 + col] += acc[i][j][r]; );
  }
}
DI void p10_cvt_p(const Params& P) {
  u16* PB = (u16*)(P.ws + PB_OFF);
  const float4* p4 = (const float4*)P.p;
  for (int e = blockIdx.x * NTHR + threadIdx.x; e < T * 256 / 4; e += gridDim.x * NTHR) {
    float4 v = p4[e]; uint2 o; o.x = pack2(v.x, v.y); o.y = pack2(v.z, v.w);
    *(uint2*)(PB + (size_t)e * 4) = o;
  }
}
DI void p11_ple(const Params& P, char* smem) {
  const u16* PB = (const u16*)(P.ws + PB_OFF); const u16* HP = (const u16*)(P.ws + HP_OFF); const u16* WB = (const u16*)P.ws;
  u16* PE = (u16*)(P.ws + PE_OFF);
  for (int t = blockIdx.x; t < 64 * 8; t += gridDim.x) {
    const int m0 = (t / 8) * 256, n0 = (t % 8) * 128;
    f32x4 acc[4][4]; zero_acc(acc);
    gemm_main(PB, 256, WB + WT_PL, 256, 256, m0, n0, acc, smem);
    EPI_LOOP( PE[(size_t)row * 1024 + col] = f2bf(acc[i][j][r]); );
  }
  for (int t = blockIdx.x; t < 64 * 8; t += gridDim.x) {
    const int m0 = (t / 8) * 256, n0 = (t % 8) * 128;
    f32x4 acc[4][4]; zero_acc(acc);
    gemm_main(HP, 1024, WB + WT_PG, 1024, 1024, m0, n0, acc, smem);
    EPI_LOOP( P.out[(size_t)row * 1024 + col] += bf2f(PE[(size_t)row * 1024 + col]) * sigmoidf(acc[i][j][r]); );
  }
}

constexpr int NPHASE = 12;
__global__ void __launch_bounds__(NTHR) mega(Params P, int ph_lo, int ph_hi) {
  extern __shared__ __attribute__((aligned(16))) char smem[];
#define PHASE(n, body) if (ph_lo <= (n) && (n) < ph_hi) { body; if ((n) + 1 < ph_hi) cg::this_grid().sync(); }
  PHASE(0, p0_prep(P, smem); rmsnorm_rows(P.x, P.norm_mix, (u16*)P.out))
  PHASE(1, p1_proj(P, smem))
  PHASE(2, p2_attn(P, smem); p2_prep(P, smem))
  PHASE(3, p3_scan(P, smem))
  PHASE(4, p4_final(P, smem))
  PHASE(5, p5_merge(P, smem))
  PHASE(6, p6_outproj(P, smem))
  PHASE(7, rmsnorm_rows(P.out, P.norm_ffn, (u16*)(P.ws + HF_OFF)))
  PHASE(8, p8_ff1(P, smem))
  PHASE(9, p9_ff2(P, smem))
  PHASE(10, rmsnorm_rows(P.out, P.norm_ple, (u16*)(P.ws + HP_OFF)); p10_cvt_p(P))
  PHASE(11, p11_ple(P, smem))
#undef PHASE
}

extern "C" void kernel_launch(void* const* d_in, const int* in_sizes, int n_in, void* d_out, int out_size, void* d_ws,
                              size_t ws_size, hipStream_t stream) {
  static int grid = 0;
  if (grid == 0) {
    int dev = 0, cus = 0, per_cu = 0;
    hipGetDevice(&dev);
    hipDeviceGetAttribute(&cus, hipDeviceAttributeMultiprocessorCount, dev);
    hipFuncSetAttribute((const void*)mega, hipFuncAttributeMaxDynamicSharedMemorySize, LDS_BYTES);
    hipOccupancyMaxActiveBlocksPerMultiprocessor(&per_cu, (const void*)mega, NTHR, LDS_BYTES);
    if (per_cu < 1) per_cu = 1;
    grid = cus * per_cu;
    if (ws_size < 268435456ull) fprintf(stderr, "kernel_launch: workspace too small: %zu\n", ws_size);
    fprintf(stderr, "kernel_launch: grid %d (cus %d x %d)\n", grid, cus, per_cu);
  }
  Params P{};
  const float** pp = (const float**)&P;
  for (int i = 0; i < 27; ++i) pp[i] = (const float*)d_in[i];
  P.out = (float*)d_out; P.ws = (char*)d_ws;
#if ONE_LAUNCH
  int lo = 0, hi = NPHASE;
  void* args[] = {&P, &lo, &hi};
  hipError_t e = hipLaunchCooperativeKernel((const void*)mega, dim3(grid), dim3(NTHR), args, LDS_BYTES, stream);
  if (e != hipSuccess) fprintf(stderr, "cooperative launch failed: %s\n", hipGetErrorString(e));
#else
  for (int ph = 0; ph < NPHASE; ++ph) hipLaunchKernelGGL(mega, dim3(grid), dim3(NTHR), LDS_BYTES, stream, P, ph, ph + 1);
#endif
}
```

```cpp
#include <hip/hip_runtime.h>
#include <hip/hip_cooperative_groups.h>
#include <cstdio>
namespace cg = cooperative_groups;

#define DI __device__ __forceinline__
typedef unsigned short u16;
using bf16x8 = __attribute__((ext_vector_type(8))) short;
using f32x4 = __attribute__((ext_vector_type(4))) float;

constexpr int T = 16384, S = 4096;
constexpr int NTHR = 512;
constexpr int LDS_BYTES = 131072 + 64;
#ifndef ONE_LAUNCH
#define ONE_LAUNCH 1
#endif

constexpr size_t WT_IN = 0, WT_UA = 4718592, WT_UR = 5242880, WT_OUT = 5767168, WT_FF1 = 6815744,
                 WT_FF2 = 11010048, WT_PG = 15204352, WT_PL = 16252928;
constexpr size_t ROT_OFF = 33030144;
constexpr size_t G2T_OFF = 33310208;
constexpr size_t W2T_OFF = 201326592;
constexpr size_t QKV_OFF = 33554432;
constexpr size_t K_OFF = QKV_OFF + 16777216, VT_OFF = K_OFF + 4194304;
constexpr size_t ZR_OFF = 58720256;
constexpr size_t GATES_OFF = 117440512;
constexpr size_t ATTN_OFF = 184549376;
constexpr size_t Y_OFF = 201326592;
constexpr size_t RW_OFF = QKV_OFF;
constexpr size_t MERGED_OFF = ZR_OFF;
constexpr size_t HF_OFF = Y_OFF;
constexpr size_t HID_OFF = QKV_OFF;
constexpr size_t HP_OFF = Y_OFF + 33554432;
constexpr size_t PB_OFF = ATTN_OFF;
constexpr size_t PE_OFF = QKV_OFF;

struct Params {
  const float *x, *p, *norm_mix, *w_in, *shift_mu, *q_norm, *k_norm, *sink, *w0, *w2, *a0, *a2, *g2, *k_k, *k_a,
      *r_k, *lnx_w, *lnx_b, *w_up_attn, *w_up_rwkv, *w_out, *norm_ffn, *w_ff1, *w_ff2, *norm_ple, *w_ple_gate, *w_ple;
  float* out;
  char* ws;
};

typedef float f32x2v __attribute__((ext_vector_type(2)));
typedef __bf16 bf16x2v __attribute__((ext_vector_type(2)));
DI unsigned pack2(float a, float b) { f32x2v f = {a, b}; return __builtin_bit_cast(unsigned, __builtin_convertvector(f, bf16x2v)); }
DI u16 f2bf(float x) { return (u16)(pack2(x, 0.f) & 0xffffu); }
DI float bf2f(u16 h) { return __uint_as_float(((unsigned)h) << 16); }
DI float bflo(unsigned w) { return __uint_as_float(w << 16); }
DI float bfhi(unsigned w) { return __uint_as_float(w & 0xffff0000u); }
DI uint2 pack4(f32x4 v) { return make_uint2(pack2(v[0], v[1]), pack2(v[2], v[3])); }
DI void unpack8(const uint4 w, float (&f)[8]) { f[0] = bflo(w.x); f[1] = bfhi(w.x); f[2] = bflo(w.y); f[3] = bfhi(w.y); f[4] = bflo(w.z); f[5] = bfhi(w.z); f[6] = bflo(w.w); f[7] = bfhi(w.w); }
DI uint4 pack8(f32x4 a, f32x4 b) { return make_uint4(pack2(a[0], a[1]), pack2(a[2], a[3]), pack2(b[0], b[1]), pack2(b[2], b[3])); }
DI float vmax_raw(float a, float b) { float r; asm("v_max_f32 %0, %1, %2" : "=v"(r) : "v"(a), "v"(b)); return r; }
DI float vmax3_raw(float a, float b, float c) { float r; asm("v_max3_f32 %0, %1, %2, %3" : "=v"(r) : "v"(a), "v"(b), "v"(c)); return r; }
DI float relu_raw(float a) { float r; asm("v_max_f32 %0, 0, %1" : "=v"(r) : "v"(a)); return r; }
DI int tid_fresh() { int t = threadIdx.x; asm volatile("" : "+v"(t)); return t; }
DI float sigmoidf(float x) { return __builtin_amdgcn_rcpf(1.f + __expf(-x)); }
DI float wave_sum(float v) { for (int m = 32; m >= 1; m >>= 1) v += __shfl_xor(v, m); return v; }
DI float wave_max(float v) { for (int m = 32; m >= 1; m >>= 1) v = fmaxf(v, __shfl_xor(v, m)); return v; }
template <int CTRL> DI float dppf(float x) {
  return __int_as_float(__builtin_amdgcn_update_dpp(0, __float_as_int(x), CTRL, 0xF, 0xF, true));
}
DI float row16_sum(float v) {
  v += dppf<0xB1>(v);
  v += dppf<0x4E>(v);
  v += dppf<0x141>(v);
  v += dppf<0x140>(v);
  return v;
}
DI float zshift(const u16* ZR, int t, int s, int col, float mu) {
  float z = bf2f(ZR[(size_t)t * 1792 + col]);
  float pv = s > 0 ? bf2f(ZR[(size_t)(t - 1) * 1792 + col]) : 0.f;
  float nx = s < S - 1 ? bf2f(ZR[(size_t)(t + 1) * 1792 + col]) : 0.f;
  return z + mu * (0.5f * (pv + nx) - z);
}

DI void p0_prep(const Params& P, char* smem) {
  const int tid = tid_fresh();
  float* tile = (float*)smem;
  u16* WB = (u16*)P.ws;
  for (int t = blockIdx.x; t < 4080; t += gridDim.x) {
    const float* src; u16* dst; int K, N, lt;
    if (t < 1152) { src = P.w_in; dst = WB + WT_IN; K = 1024; N = 4608; lt = t; }
    else if (t < 1280) { src = P.w_up_attn; dst = WB + WT_UA; K = 512; N = 1024; lt = t - 1152; }
    else if (t < 1408) { src = P.w_up_rwkv; dst = WB + WT_UR; K = 512; N = 1024; lt = t - 1280; }
    else if (t < 1664) { src = P.w_out; dst = WB + WT_OUT; K = 1024; N = 1024; lt = t - 1408; }
    else if (t < 2688) { src = P.w_ff1; dst = WB + WT_FF1; K = 1024; N = 4096; lt = t - 1664; }
    else if (t < 3712) { src = P.w_ff2; dst = WB + WT_FF2; K = 4096; N = 1024; lt = t - 2688; }
    else if (t < 3968) { src = P.w_ple_gate; dst = WB + WT_PG; K = 1024; N = 1024; lt = t - 3712; }
    else if (t < 4032) { src = P.w_ple; dst = WB + WT_PL; K = 256; N = 1024; lt = t - 3968; }
    else if (t < 4064) { const int mi = (t - 4032) >> 3; src = ((mi & 1) ? P.a2 : P.w2) + (size_t)(mi >> 1) * 64 * 512; dst = (u16*)(P.ws + W2T_OFF) + (size_t)mi * 512 * 64; K = 64; N = 512; lt = (t - 4032) & 7; }
    else { src = P.g2; dst = (u16*)(P.ws + G2T_OFF); K = 128; N = 512; lt = t - 4064; }
    const int ntn = N >> 6, k0 = (lt / ntn) * 64, n0 = (lt % ntn) * 64;
#pragma unroll
    for (int i = 0; i < 8; ++i) { int idx = i * NTHR + tid, r = idx >> 6, c = idx & 63; tile[r * 65 + c] = src[(size_t)(k0 + r) * N + n0 + c]; }
    __syncthreads();
#pragma unroll
    for (int i = 0; i < 8; ++i) { int idx = i * NTHR + tid, n = idx >> 6, k = idx & 63; dst[(size_t)(n0 + n) * K + k0 + k] = f2bf(tile[k * 65 + n]); }
    __syncthreads();
  }
  float* ROT = (float*)(P.ws + ROT_OFF);
  for (int e = blockIdx.x * NTHR + tid; e < 32768; e += gridDim.x * NTHR) {
    int pos = e >> 3, i = e & 7;
    float invf = i == 0 ? 1.0f : i == 1 ? 0.19392274f : i == 2 ? 0.03760603f : i == 3 ? 0.0072926646f
               : i == 4 ? 0.0014142136f : i == 5 ? 0.0002742482f : i == 6 ? 5.3182957e-05f : 1.0313385e-05f;
    float ang = (float)pos * invf;
    double a = (double)ang;
    double kq = rint(a * 0.15915494309189535);
    float rf = (float)(a - kq * 6.283185307179586476925);
    ROT[e] = cosf(rf); ROT[32768 + e] = sinf(rf);
  }
}

DI void rmsnorm_rows(const float* src, const float* gain, u16* dst) {
  const int tid = tid_fresh(), lane = tid & 63;
  const int nw = gridDim.x * 8;
  float4 g[4];
#pragma unroll
  for (int i = 0; i < 4; ++i) g[i] = ((const float4*)gain)[lane + i * 64];
  for (int row = blockIdx.x * 8 + (tid >> 6); row < T; row += 4 * nw) {
    float4 v[4][4]; float ss[4];
#pragma unroll
    for (int r = 0; r < 4; ++r) {
      const float4* s4 = (const float4*)(src + (size_t)(row + r * nw) * 1024);
      ss[r] = 0.f;
#pragma unroll
      for (int i = 0; i < 4; ++i) { v[r][i] = (row + r * nw < T) ? s4[lane + i * 64] : make_float4(0.f, 0.f, 0.f, 0.f); }
    }
#pragma unroll
    for (int r = 0; r < 4; ++r) {
#pragma unroll
      for (int i = 0; i < 4; ++i) ss[r] += v[r][i].x * v[r][i].x + v[r][i].y * v[r][i].y + v[r][i].z * v[r][i].z + v[r][i].w * v[r][i].w;
      ss[r] = wave_sum(ss[r]);
      const float sc = rsqrtf(ss[r] * (1.f / 1024.f) + 1e-6f);
      if (row + r * nw < T)
#pragma unroll
      for (int i = 0; i < 4; ++i) {
        uint2 o; o.x = pack2(v[r][i].x * sc * g[i].x, v[r][i].y * sc * g[i].y); o.y = pack2(v[r][i].z * sc * g[i].z, v[r][i].w * sc * g[i].w);
        *(uint2*)(dst + (size_t)(row + r * nw) * 1024 + (lane + i * 64) * 4) = o;
      }
    }
  }
}

namespace pg8 {
#define PG8_LAS __attribute__((address_space(3)))
typedef unsigned short bf16_t;
typedef short bf16x8 __attribute__((ext_vector_type(8)));
typedef float f32x4 __attribute__((ext_vector_type(4)));
typedef unsigned u32x4 __attribute__((ext_vector_type(4)));
constexpr int BM = 256, BK = 64, HALF = 128, HTB = HALF * BK * 2  , STAGE_BYTES = 8 * HTB, NXCD = 8, WGM = 4;

__host__ __device__ __forceinline__ int lds_byte(int r, int c) { const int st = (r >> 4) * 2 + (c >> 5), rr = r & 15, cc = c & 31, ob = rr * 64 + cc * 2; return st * 1024 + (ob ^ (((ob >> 9) & 1) << 5)); }
__host__ __device__ __forceinline__ void stage_rc(int b, int& R, int& C) { const int st = b / 1024, sb = b % 1024, swz = sb ^ (((sb >> 9) & 1) << 5); R = (st >> 1) * 16 + swz / 64; C = (st & 1) * 32 + (swz % 64) / 2; }
__host__ __device__ __forceinline__ int perm32(int rho) { const int n = rho >> 4, i = rho & 15; return 8 * (i >> 2) + 4 * n + (i & 3); }

struct Unit { int pm, pn; };
struct Gemm { const bf16_t* A; const bf16_t* Bt; int M, N, K; };

struct StaticOrder {
    int nM, nN, nwg, G, c;
    __host__ __device__ void init(int M, int N, int G_, int c_) { nM = M / BM; nN = N / BM; nwg = nM * nN; G = G_; c = c_; }
    __host__ __device__ bool next(int i, Unit& u) const {
        const long L = (long)i * G + c; if (L >= nwg) return false;
        int wgid = (int)L; { const int q = nwg / NXCD, r = nwg % NXCD, xcd = wgid % NXCD, off = wgid / NXCD; wgid = (xcd < r ? xcd * (q + 1) : r * (q + 1) + (xcd - r) * q) + off; }
        const int nig = WGM * nN, gid = wgid / nig, fm = gid * WGM, gsz = (nM - fm) < WGM ? (nM - fm) : WGM;
        u.pm = fm + ((wgid % nig) % gsz); u.pn = (wgid % nig) / gsz; return true;
    }
    __device__ __forceinline__ void a_ready(const Unit&) const {}
    __device__ __forceinline__ void done(const Unit&) const {}
};
template <class Epi, class Sched, bool STAMP = false>
__device__ __forceinline__ void gemm_phase(PG8_LAS unsigned char* lds, const Gemm g, const Sched& S, const Epi& E, unsigned long long* stamps) {
    const int tid = tid_fresh(), wid = __builtin_amdgcn_readfirstlane(tid >> 6), lane = tid & 63, wr = wid >> 2, wc = wid & 3, fr = lane & 15, fq = lane >> 4;
    const int K = g.K, nt = K / BK;
    int ts_lo = 0, ts_hi = 0, nts = 0; const unsigned long long rt_entry = STAMP ? (unsigned long long)wall_clock64() : 0ull;
#define PG8_STAMP() do { if (STAMP && wid == 0 && nts < 64) { const unsigned long long _c = (unsigned long long)clock64(); \
        ts_lo = (lane == nts) ? (int)(unsigned)_c : ts_lo; ts_hi = (lane == nts) ? (int)(unsigned)(_c >> 32) : ts_hi; ++nts; } } while (0)
    PG8_STAMP();
    unsigned voffA[2], voffB[2];
#pragma unroll
    for (int i = 0; i < 2; ++i) { int R, C; stage_rc(tid * 16 + i * 8192, R, C); const int Rb = Epi::PERM ? ((R & ~31) + perm32(R & 31)) : R;
        voffA[i] = (unsigned)(R * K + C) * 2u; voffB[i] = (unsigned)(Rb * K + C) * 2u; }
    const size_t kstep = (size_t)(BK * 2);
    const size_t hstep = (size_t)HALF * K * 2;
    const size_t tstep = 2 * hstep;
    const unsigned ldsw = (unsigned)wid * 1024u;
    const int aoff = lds_byte(wr * 64 + fr, fq * 8), boff = lds_byte(wc * 32 + fr, fq * 8);
#define PG8_SA(b, h) (((b) * 2 + (h)) * HTB)
#define PG8_SB(b, h) ((4 + (b) * 2 + (h)) * HTB)
#define PG8_STAGE(bufoff, gbase, voff) do { _Pragma("unroll") for (int _i = 0; _i < 2; ++_i) \
        __builtin_amdgcn_global_load_lds((const unsigned*)((const char*)(gbase) + (voff)[_i]), (PG8_LAS unsigned*)(lds + (bufoff) + ldsw + _i * 8192), 16, 0, 0); } while (0)
#define PG8_LDA(dst, b, h) do { _Pragma("unroll") for (int m = 0; m < 4; ++m) _Pragma("unroll") for (int k = 0; k < 2; ++k) dst[m][k] = *(const PG8_LAS bf16x8*)(lds + PG8_SA(b, h) + aoff + m * 2048 + k * 1024); } while (0)
#define PG8_LDB(dst, b, h) do { _Pragma("unroll") for (int n = 0; n < 2; ++n) _Pragma("unroll") for (int k = 0; k < 2; ++k) dst[n][k] = *(const PG8_LAS bf16x8*)(lds + PG8_SB(b, h) + boff + n * 2048 + k * 1024); } while (0)
#define PG8_MMA(ai, bj, At, Bt) do { __builtin_amdgcn_s_setprio(1); _Pragma("unroll") for (int m = 0; m < 4; ++m) _Pragma("unroll") for (int n = 0; n < 2; ++n) _Pragma("unroll") for (int k = 0; k < 2; ++k) \
        acc[ai][bj][m][n] = __builtin_amdgcn_mfma_f32_16x16x32_bf16(Bt[n][k], At[m][k], acc[ai][bj][m][n], 0, 0, 0); __builtin_amdgcn_s_setprio(0); } while (0)
#define PG8_WAIT_V(n) asm volatile("s_waitcnt vmcnt(" #n ")" ::: "memory")
#define PG8_WAIT_L(n) asm volatile("s_waitcnt lgkmcnt(" #n ")" ::: "memory")
#define PG8_BAR __builtin_amdgcn_s_barrier()
#define PG8_SCHED __builtin_amdgcn_sched_barrier(0)
    Unit cur, nxt; int ui = 0;
    if (!S.next(0, cur)) return;
    f32x4 acc[2][2][4][2];
#pragma unroll
    for (int a = 0; a < 2; ++a)
#pragma unroll
        for (int b = 0; b < 2; ++b)
#pragma unroll
            for (int m = 0; m < 4; ++m)
#pragma unroll
                for (int n = 0; n < 2; ++n) acc[a][b][m][n] = (f32x4){0.f, 0.f, 0.f, 0.f};
    bf16x8 At[4][2], B0[2][2], B1[2][2];
    const char* cA = (const char*)g.A + (size_t)cur.pm * tstep; const char* cB = (const char*)g.Bt + (size_t)cur.pn * tstep;
    S.a_ready(cur);
    PG8_STAGE(PG8_SB(0, 0), cB, voffB); PG8_STAGE(PG8_SA(0, 0), cA, voffA); PG8_STAGE(PG8_SB(0, 1), cB + hstep, voffB); PG8_STAGE(PG8_SA(0, 1), cA + hstep, voffA);
    if (wr == 1) PG8_BAR;
    PG8_WAIT_V(4); PG8_BAR;
    PG8_STAGE(PG8_SB(1, 0), cB + kstep, voffB); PG8_STAGE(PG8_SA(1, 0), cA + kstep, voffA); PG8_STAGE(PG8_SB(1, 1), cB + hstep + kstep, voffB);
    PG8_WAIT_V(6); PG8_BAR;
    PG8_STAMP();
    for (;;) {
        const bool has_next = S.next(ui + 1, nxt);
        const char* nA = has_next ? (const char*)g.A + (size_t)nxt.pm * tstep : cA; const char* nB = has_next ? (const char*)g.Bt + (size_t)nxt.pn * tstep : cB;
        for (int t = 0; t < nt; t += 2) {
            const bool last = (t == nt - 2);
            const char* a1 = cA + (size_t)(t + 1) * kstep;
            const char* a2 = last ? nA : cA + (size_t)(t + 2) * kstep; const char* b2 = last ? nB : cB + (size_t)(t + 2) * kstep;
            const char* a3 = a2 + kstep; const char* b3 = b2 + kstep;
            if (last && has_next) S.a_ready(nxt);
            PG8_LDB(B0, 0, 0); PG8_SCHED; PG8_LDA(At, 0, 0); PG8_STAGE(PG8_SA(1, 1), a1 + hstep, voffA);
            PG8_WAIT_L(8); PG8_BAR; PG8_WAIT_L(0); PG8_MMA(0, 0, At, B0); PG8_BAR; PG8_SCHED;
            PG8_LDB(B1, 0, 1); PG8_STAGE(PG8_SB(0, 0), b2, voffB);
            PG8_BAR; PG8_WAIT_L(0); PG8_MMA(0, 1, At, B1); PG8_BAR;
            PG8_LDA(At, 0, 1); PG8_STAGE(PG8_SA(0, 0), a2, voffA);
            PG8_BAR; PG8_WAIT_L(0); PG8_MMA(1, 0, At, B0); PG8_BAR; PG8_SCHED;
            PG8_STAGE(PG8_SB(0, 1), b2 + hstep, voffB);
            PG8_WAIT_V(6); PG8_BAR; PG8_MMA(1, 1, At, B1); PG8_BAR;
            PG8_LDB(B0, 1, 0); PG8_SCHED; PG8_LDA(At, 1, 0); PG8_STAGE(PG8_SA(0, 1), a2 + hstep, voffA);
            PG8_WAIT_L(8); PG8_BAR; PG8_WAIT_L(0); PG8_MMA(0, 0, At, B0); PG8_BAR; PG8_SCHED;
            PG8_LDB(B1, 1, 1); PG8_STAGE(PG8_SB(1, 0), b3, voffB);
            PG8_BAR; PG8_WAIT_L(0); PG8_MMA(0, 1, At, B1); PG8_BAR;
            PG8_LDA(At, 1, 1); PG8_STAGE(PG8_SA(1, 0), a3, voffA);
            PG8_BAR; PG8_WAIT_L(0); PG8_MMA(1, 0, At, B0); PG8_BAR; PG8_SCHED;
            PG8_STAGE(PG8_SB(1, 1), b3 + hstep, voffB);
            PG8_WAIT_V(6); PG8_BAR; PG8_MMA(1, 1, At, B1); PG8_BAR;
        }
        PG8_STAMP();
        if constexpr (!Epi::AFTER_DRAIN) { E(acc, cur, wr, wc, fr, fq); S.done(cur); }
        PG8_STAMP();
        if (!has_next) break;
#pragma unroll
        for (int a = 0; a < 2; ++a)
#pragma unroll
            for (int b = 0; b < 2; ++b)
#pragma unroll
                for (int m = 0; m < 4; ++m)
#pragma unroll
                    for (int n = 0; n < 2; ++n) acc[a][b][m][n] = (f32x4){0.f, 0.f, 0.f, 0.f};
        cur = nxt; cA = nA; cB = nB; ++ui;
    }
    PG8_WAIT_V(0);
    if (wr == 0) PG8_BAR;
    PG8_BAR;
    if constexpr (Epi::AFTER_DRAIN) { E.fused(acc, cur, wr, wc, fr, fq, lds, wid, lane); S.done(cur); }
    PG8_STAMP();
    if (STAMP && wid == 0) { stamps[lane] = lane < nts ? (((unsigned long long)(unsigned)ts_hi << 32) | (unsigned)ts_lo) : 0ull;
        if (lane == 62) stamps[62] = rt_entry; if (lane == 63) stamps[63] = (unsigned long long)wall_clock64(); }
#undef PG8_STAMP
#undef PG8_SA
#undef PG8_SB
#undef PG8_STAGE
#undef PG8_LDA
#undef PG8_LDB
#undef PG8_MMA
#undef PG8_WAIT_V
#undef PG8_WAIT_L
#undef PG8_BAR
#undef PG8_SCHED
}
template <class Epi, class Sched, bool STAMP = false>
__device__ __forceinline__ void gemm_phase_cat(PG8_LAS unsigned char* lds, const Gemm g, const bf16_t* A2, const bf16_t* Bt2, const Sched& S, const Epi& E, unsigned long long* stamps) {
    const int tid = tid_fresh(), wid = __builtin_amdgcn_readfirstlane(tid >> 6), lane = tid & 63, wr = wid >> 2, wc = wid & 3, fr = lane & 15, fq = lane >> 4;
    const int K = g.K, nth = K / BK, nt = 2 * nth;
    int ts_lo = 0, ts_hi = 0, nts = 0; const unsigned long long rt_entry = STAMP ? (unsigned long long)wall_clock64() : 0ull;
#define PG8_STAMP() do { if (STAMP && wid == 0 && nts < 64) { const unsigned long long _c = (unsigned long long)clock64(); \
        ts_lo = (lane == nts) ? (int)(unsigned)_c : ts_lo; ts_hi = (lane == nts) ? (int)(unsigned)(_c >> 32) : ts_hi; ++nts; } } while (0)
    PG8_STAMP();
    unsigned voffA[2], voffB[2];
#pragma unroll
    for (int i = 0; i < 2; ++i) { int R, C; stage_rc(tid * 16 + i * 8192, R, C); const int Rb = Epi::PERM ? ((R & ~31) + perm32(R & 31)) : R;
        voffA[i] = (unsigned)(R * K + C) * 2u; voffB[i] = (unsigned)(Rb * K + C) * 2u; }
    const size_t kstep = (size_t)(BK * 2);
    const size_t hstep = (size_t)HALF * K * 2;
    const size_t tstep = 2 * hstep;
    const unsigned ldsw = (unsigned)wid * 1024u;
    const int aoff = lds_byte(wr * 64 + fr, fq * 8), boff = lds_byte(wc * 32 + fr, fq * 8);
#define PG8_SA(b, h) (((b) * 2 + (h)) * HTB)
#define PG8_SB(b, h) ((4 + (b) * 2 + (h)) * HTB)
#define PG8_STAGE(bufoff, gbase, voff) do { _Pragma("unroll") for (int _i = 0; _i < 2; ++_i) \
        __builtin_amdgcn_global_load_lds((const unsigned*)((const char*)(gbase) + (voff)[_i]), (PG8_LAS unsigned*)(lds + (bufoff) + ldsw + _i * 8192), 16, 0, 0); } while (0)
#define PG8_LDA(dst, b, h) do { _Pragma("unroll") for (int m = 0; m < 4; ++m) _Pragma("unroll") for (int k = 0; k < 2; ++k) dst[m][k] = *(const PG8_LAS bf16x8*)(lds + PG8_SA(b, h) + aoff + m * 2048 + k * 1024); } while (0)
#define PG8_LDB(dst, b, h) do { _Pragma("unroll") for (int n = 0; n < 2; ++n) _Pragma("unroll") for (int k = 0; k < 2; ++k) dst[n][k] = *(const PG8_LAS bf16x8*)(lds + PG8_SB(b, h) + boff + n * 2048 + k * 1024); } while (0)
#define PG8_MMA(ai, bj, At, Bt) do { __builtin_amdgcn_s_setprio(1); _Pragma("unroll") for (int m = 0; m < 4; ++m) _Pragma("unroll") for (int n = 0; n < 2; ++n) _Pragma("unroll") for (int k = 0; k < 2; ++k) \
        acc[ai][bj][m][n] = __builtin_amdgcn_mfma_f32_16x16x32_bf16(Bt[n][k], At[m][k], acc[ai][bj][m][n], 0, 0, 0); __builtin_amdgcn_s_setprio(0); } while (0)
#define PG8_WAIT_V(n) asm volatile("s_waitcnt vmcnt(" #n ")" ::: "memory")
#define PG8_WAIT_L(n) asm volatile("s_waitcnt lgkmcnt(" #n ")" ::: "memory")
#define PG8_BAR __builtin_amdgcn_s_barrier()
#define PG8_SCHED __builtin_amdgcn_sched_barrier(0)
    Unit cur, nxt; int ui = 0;
    if (!S.next(0, cur)) return;
    f32x4 acc[2][2][4][2];
#pragma unroll
    for (int a = 0; a < 2; ++a)
#pragma unroll
        for (int b = 0; b < 2; ++b)
#pragma unroll
            for (int m = 0; m < 4; ++m)
#pragma unroll
                for (int n = 0; n < 2; ++n) acc[a][b][m][n] = (f32x4){0.f, 0.f, 0.f, 0.f};
    bf16x8 At[4][2], B0[2][2], B1[2][2];
    const char* cA = (const char*)g.A + (size_t)cur.pm * tstep; const char* cB = (const char*)g.Bt + (size_t)cur.pn * tstep;
    const char* cA2 = (const char*)A2 + (size_t)cur.pm * tstep; const char* cB2 = (const char*)Bt2 + (size_t)cur.pn * tstep;
    S.a_ready(cur);
    PG8_STAGE(PG8_SB(0, 0), cB, voffB); PG8_STAGE(PG8_SA(0, 0), cA, voffA); PG8_STAGE(PG8_SB(0, 1), cB + hstep, voffB); PG8_STAGE(PG8_SA(0, 1), cA + hstep, voffA);
    if (wr == 1) PG8_BAR;
    PG8_WAIT_V(4); PG8_BAR;
    PG8_STAGE(PG8_SB(1, 0), cB + kstep, voffB); PG8_STAGE(PG8_SA(1, 0), cA + kstep, voffA); PG8_STAGE(PG8_SB(1, 1), cB + hstep + kstep, voffB);
    PG8_WAIT_V(6); PG8_BAR;
    PG8_STAMP();
    for (;;) {
        const bool has_next = S.next(ui + 1, nxt);
        const char* nA = has_next ? (const char*)g.A + (size_t)nxt.pm * tstep : cA; const char* nB = has_next ? (const char*)g.Bt + (size_t)nxt.pn * tstep : cB;
        for (int t = 0; t < nt; t += 2) {
            const bool last = (t == nt - 2);
            const char* a1 = (t < nth ? cA : cA2 - (size_t)nth * kstep) + (size_t)(t + 1) * kstep;
            const char* a2 = last ? nA : (t + 2 < nth ? cA : cA2 - (size_t)nth * kstep) + (size_t)(t + 2) * kstep;
            const char* b2 = last ? nB : (t + 2 < nth ? cB : cB2 - (size_t)nth * kstep) + (size_t)(t + 2) * kstep;
            if (t == nth) E.mid(acc, cur, wr, wc, fr, fq);
            const char* a3 = a2 + kstep; const char* b3 = b2 + kstep;
            if (last && has_next) S.a_ready(nxt);
            PG8_LDB(B0, 0, 0); PG8_SCHED; PG8_LDA(At, 0, 0); PG8_STAGE(PG8_SA(1, 1), a1 + hstep, voffA);
            PG8_WAIT_L(8); PG8_BAR; PG8_WAIT_L(0); PG8_MMA(0, 0, At, B0); PG8_BAR; PG8_SCHED;
            PG8_LDB(B1, 0, 1); PG8_STAGE(PG8_SB(0, 0), b2, voffB);
            PG8_BAR; PG8_WAIT_L(0); PG8_MMA(0, 1, At, B1); PG8_BAR;
            PG8_LDA(At, 0, 1); PG8_STAGE(PG8_SA(0, 0), a2, voffA);
            PG8_BAR; PG8_WAIT_L(0); PG8_MMA(1, 0, At, B0); PG8_BAR; PG8_SCHED;
            PG8_STAGE(PG8_SB(0, 1), b2 + hstep, voffB);
            PG8_WAIT_V(6); PG8_BAR; PG8_MMA(1, 1, At, B1); PG8_BAR;
            PG8_LDB(B0, 1, 0); PG8_SCHED; PG8_LDA(At, 1, 0); PG8_STAGE(PG8_SA(0, 1), a2 + hstep, voffA);
            PG8_WAIT_L(8); PG8_BAR; PG8_WAIT_L(0); PG8_MMA(0, 0, At, B0); PG8_BAR; PG8_SCHED;
            PG8_LDB(B1, 1, 1); PG8_STAGE(PG8_SB(1, 0), b3, voffB);
            PG8_BAR; PG8_WAIT_L(0); PG8_MMA(0, 1, At, B1); PG8_BAR;
            PG8_LDA(At, 1, 1); PG8_STAGE(PG8_SA(1, 0), a3, voffA);
            PG8_BAR; PG8_WAIT_L(0); PG8_MMA(1, 0, At, B0); PG8_BAR; PG8_SCHED;
            PG8_STAGE(PG8_SB(1, 1), b3 + hstep, voffB);
            PG8_WAIT_V(6); PG8_BAR; PG8_MMA(1, 1, At, B1); PG8_BAR;
        }
        PG8_STAMP();
        if constexpr (!Epi::AFTER_DRAIN) { E(acc, cur, wr, wc, fr, fq); S.done(cur); }
        PG8_STAMP();
        if (!has_next) break;
#pragma unroll
        for (int a = 0; a < 2; ++a)
#pragma unroll
            for (int b = 0; b < 2; ++b)
#pragma unroll
                for (int m = 0; m < 4; ++m)
#pragma unroll
                    for (int n = 0; n < 2; ++n) acc[a][b][m][n] = (f32x4){0.f, 0.f, 0.f, 0.f};
        cur = nxt; cA = nA; cB = nB; cA2 = (const char*)A2 + (size_t)cur.pm * tstep; cB2 = (const char*)Bt2 + (size_t)cur.pn * tstep; ++ui;
    }
    PG8_WAIT_V(0);
    if (wr == 0) PG8_BAR;
    PG8_BAR;
    if constexpr (Epi::AFTER_DRAIN) { E.fused(acc, cur, wr, wc, fr, fq, lds, wid, lane); S.done(cur); }
    PG8_STAMP();
    if (STAMP && wid == 0) { stamps[lane] = lane < nts ? (((unsigned long long)(unsigned)ts_hi << 32) | (unsigned)ts_lo) : 0ull;
        if (lane == 62) stamps[62] = rt_entry; if (lane == 63) stamps[63] = (unsigned long long)wall_clock64(); }
#undef PG8_STAMP
#undef PG8_SA
#undef PG8_SB
#undef PG8_STAGE
#undef PG8_LDA
#undef PG8_LDB
#undef PG8_MMA
#undef PG8_WAIT_V
#undef PG8_WAIT_L
#undef PG8_BAR
#undef PG8_SCHED
}
}
using pg8::Unit;
#define XB_TMO      128
#define XB_XCNT(j)  (256  + 64 * (j))
#define XB_XSUB(j)  (1280 + 64 * (j))
#define XB_XGEN(j)  (2304 + 64 * (j))
#define XB_TOP      3328
#define XB_TOPGEN   3392
#define XCD_BAR_WORDS 3456
#define XB_SPIN_CAP (1u << 18)
#define LAS __attribute__((address_space(3)))

__device__ __forceinline__ unsigned xb_ld(unsigned* p)              { return __hip_atomic_load(p, __ATOMIC_RELAXED, __HIP_MEMORY_SCOPE_AGENT); }
__device__ __forceinline__ unsigned xb_add(unsigned* p, unsigned v) { return __hip_atomic_fetch_add(p, v, __ATOMIC_RELAXED, __HIP_MEMORY_SCOPE_AGENT); }
__device__ __forceinline__ unsigned xb_xcc_id() { return (unsigned)__builtin_amdgcn_s_getreg((3 << 11) | 20) & 0xFu; }
#define XB_SPIN(cond, bar) do { unsigned _sp = 0; while (cond) { __builtin_amdgcn_s_sleep(1); \
    if ((++_sp & 255u) == 0u) { if (xb_ld(&(bar)[XB_TMO])) break; if (_sp > XB_SPIN_CAP) { atomicAdd(&(bar)[XB_TMO], 1u); break; } } } } while (0)

struct XcdBarrier {
    unsigned* bar; unsigned x;
    volatile LAS unsigned* st;
};

__device__ __forceinline__ XcdBarrier xcd_barrier_post(unsigned* bar, volatile LAS unsigned* st) {
    XcdBarrier b; b.bar = bar; b.x = xb_xcc_id(); b.st = st;
    if (threadIdx.x == 0) (void)xb_add(&bar[XB_XCNT(b.x)], 1u);
    return b;
}
__device__ __forceinline__ void xcd_barrier_complete(unsigned* bar, unsigned x, unsigned& nloc, unsigned& nx) {
    const unsigned G = gridDim.x * gridDim.y * gridDim.z;
    unsigned sum, cnt, mine, sp = 0u;
    for (;;) {
        sum = 0u; cnt = 0u; mine = 0u;
#pragma unroll
        for (unsigned j = 0; j < 16; ++j) { const unsigned c = xb_ld(&bar[XB_XCNT(j)]); sum += c; cnt += (c > 0u) ? 1u : 0u; mine = (j == x) ? c : mine; }
        if (sum == G) break;
        __builtin_amdgcn_s_sleep(1);
        if ((++sp & 255u) == 0u) { if (xb_ld(&bar[XB_TMO])) break; if (sp > XB_SPIN_CAP) { atomicAdd(&bar[XB_TMO], 1u); break; } }
    }
    nloc = mine > 0u ? mine : 1u; nx = cnt > 0u ? cnt : 1u;
}

__device__ __forceinline__ void xcd_barrier(const XcdBarrier& b) {
    asm volatile("s_waitcnt vmcnt(0)" ::: "memory");
    __syncthreads();
    if (threadIdx.x == 0) {
        unsigned* bar = b.bar;
        __builtin_amdgcn_s_waitcnt(0);
        unsigned nloc = b.st[0], nx = b.st[1];
        if (nloc == 0u) { xcd_barrier_complete(bar, b.x, nloc, nx); b.st[0] = nloc; b.st[1] = nx; }
        const unsigned old = xb_add(&bar[XB_XSUB(b.x)], 1u);
        const unsigned gen = old / nloc;
        if (old + 1u == (gen + 1u) * nloc) {
            __builtin_amdgcn_fence(__ATOMIC_RELEASE, "agent");
            asm volatile("s_waitcnt vmcnt(0)" ::: "memory");
            const unsigned og = xb_add(&bar[XB_TOP], 1u);
            const unsigned tg = og / nx;
            if (og + 1u == (tg + 1u) * nx) xb_add(&bar[XB_TOPGEN], 1u);
            else XB_SPIN(xb_ld(&bar[XB_TOPGEN]) == tg, bar);
            __builtin_amdgcn_fence(__ATOMIC_ACQUIRE, "agent");
            xb_add(&bar[XB_XGEN(b.x)], 1u);
            asm volatile("s_waitcnt vmcnt(0)" ::: "memory");
        } else {
            XB_SPIN(xb_ld(&bar[XB_XGEN(b.x)]) == gen, bar);
            __builtin_amdgcn_fence(__ATOMIC_ACQUIRE, "agent");
            asm volatile("s_waitcnt vmcnt(0)" ::: "memory");
        }
    }
    __syncthreads();
}

#define EPI_FOR(...) do { const int row0_ = u.pm * 256 + wr * 64 + fr, col0_ = u.pn * 256 + wc * 32 + 4 * fq; \
    _Pragma("unroll") for (int ai = 0; ai < 2; ++ai) _Pragma("unroll") for (int m = 0; m < 4; ++m) { const size_t row = (size_t)(row0_ + ai * 128 + m * 16); \
      _Pragma("unroll") for (int bj = 0; bj < 2; ++bj) _Pragma("unroll") for (int n = 0; n < 2; ++n) { const int col = col0_ + bj * 128 + n * 16; const f32x4 v = acc[ai][bj][m][n]; __VA_ARGS__ } \
      if (m & 1) asm volatile("" ::: "memory"); } } while (0)
#define EPI_HEAD static constexpr bool PERM = false, AFTER_DRAIN = false; \
  DI void operator()(const f32x4 (&acc)[2][2][4][2], const Unit& u, int wr, int wc, int fr, int fq) const

#define EPI_FOR8(...) do { const int row0_ = u.pm * 256 + wr * 64 + fr, col0_ = u.pn * 256 + wc * 32 + 8 * fq; \
    _Pragma("unroll") for (int ai = 0; ai < 2; ++ai) _Pragma("unroll") for (int m = 0; m < 4; ++m) { const size_t row = (size_t)(row0_ + ai * 128 + m * 16); \
      _Pragma("unroll") for (int bj = 0; bj < 2; ++bj) { const int col = col0_ + bj * 128; const f32x4 v0 = acc[ai][bj][m][0], v1 = acc[ai][bj][m][1]; __VA_ARGS__ } \
      if (m & 1) asm volatile("" ::: "memory"); } } while (0)
#define EPI_FOR8T(...) do { const int row0_ = u.pm * 256 + wr * 64 + fr, col0_ = u.pn * 256 + wc * 32 + 8 * fq; \
    _Pragma("unroll") for (int ai = 0; ai < 2; ++ai) _Pragma("unroll") for (int m = 0; m < 4; ++m) { const size_t row = (size_t)(row0_ + ai * 128 + m * 16); \
      _Pragma("unroll") for (int bj = 0; bj < 2; ++bj) { const int col = col0_ + bj * 128; const f32x4 v0 = acc[ai][bj][m][0], v1 = acc[ai][bj][m][1]; __VA_ARGS__ } \
      asm volatile("" ::: "memory"); } } while (0)
#define EPI_HEAD_P static constexpr bool PERM = true, AFTER_DRAIN = false; \
  DI void operator()(const f32x4 (&acc)[2][2][4][2], const Unit& u, int wr, int wc, int fr, int fq) const
DI f32x4 sig4(f32x4 v) { f32x4 o; o[0] = sigmoidf(v[0]); o[1] = sigmoidf(v[1]); o[2] = sigmoidf(v[2]); o[3] = sigmoidf(v[3]); return o; }
struct EpiProjP { u16 *Q, *Kb, *VT, *ZR, *GT;
  EPI_HEAD_P {
    if (u.pn < 2) { EPI_FOR8( *(uint4*)(Q + row * 512 + col) = pack8(v0, v1); ); }
    else if (u.pn == 2) {
      EPI_FOR8( if (bj == 0) { *(uint4*)(Kb + row * 128 + (col - 512)) = pack8(v0, v1); }
                else { *(uint4*)(VT + row * 128 + (col - 640)) = pack8(v0, v1); } );
    }
    else if (u.pn < 10) { EPI_FOR8( *(uint4*)(ZR + row * 1792 + (col - 768)) = pack8(v0, v1); ); }
    else { EPI_FOR8( *(uint4*)(GT + row * 2048 + (col - 2560)) = pack8(sig4(v0), sig4(v1)); ); }
  } };
struct EpiRelu2P { u16* HID;
  EPI_HEAD_P { EPI_FOR8( f32x4 a, b;
                         a[0] = relu_raw(v0[0]); a[1] = relu_raw(v0[1]); a[2] = relu_raw(v0[2]); a[3] = relu_raw(v0[3]); a = a * a;
                         b[0] = relu_raw(v1[0]); b[1] = relu_raw(v1[1]); b[2] = relu_raw(v1[2]); b[3] = relu_raw(v1[3]); b = b * b;
                         *(uint4*)(HID + row * 4096 + col) = pack8(a, b); ); } };
struct EpiMergeCatP { u16* MG; const u16* GT;
  static constexpr bool PERM = true, AFTER_DRAIN = false;
  DI void mid(f32x4 (&acc)[2][2][4][2], const Unit& u, int wr, int wc, int fr, int fq) const {
    const int row0_ = u.pm * 256 + wr * 64 + fr, col0_ = u.pn * 256 + wc * 32 + 8 * fq;
#pragma unroll
    for (int ai = 0; ai < 2; ++ai)
#pragma unroll
      for (int m = 0; m < 4; ++m) {
        const size_t row = (size_t)(row0_ + ai * 128 + m * 16);
#pragma unroll
        for (int bj = 0; bj < 2; ++bj) {
          const int col = col0_ + bj * 128;
          float g0[8], g1[8];
          unpack8(*(const uint4*)(GT + row * 2048 + col), g0); unpack8(*(const uint4*)(GT + row * 2048 + 1024 + col), g1);
#pragma unroll
          for (int e = 0; e < 4; ++e) {
            acc[ai][bj][m][0][e] *= g0[e] * __builtin_amdgcn_rcpf(fmaxf(g1[e], 1e-20f));
            acc[ai][bj][m][1][e] *= g0[4 + e] * __builtin_amdgcn_rcpf(fmaxf(g1[4 + e], 1e-20f));
          }
        }
        asm volatile("" ::: "memory");
      }
  }
  DI void operator()(const f32x4 (&acc)[2][2][4][2], const Unit& u, int wr, int wc, int fr, int fq) const {
    EPI_FOR8T( float g1[8]; unpack8(*(const uint4*)(GT + row * 2048 + 1024 + col), g1); f32x4 a, b;
              a[0] = v0[0] * fmaxf(g1[0], 1e-20f); a[1] = v0[1] * fmaxf(g1[1], 1e-20f); a[2] = v0[2] * fmaxf(g1[2], 1e-20f); a[3] = v0[3] * fmaxf(g1[3], 1e-20f);
              b[0] = v1[0] * fmaxf(g1[4], 1e-20f); b[1] = v1[1] * fmaxf(g1[5], 1e-20f); b[2] = v1[2] * fmaxf(g1[6], 1e-20f); b[3] = v1[3] * fmaxf(g1[7], 1e-20f);
              *(uint4*)(MG + row * 1024 + col) = pack8(a, b); );
  } };
struct EpiStoreBfP { u16* O;
  EPI_HEAD_P { EPI_FOR8( *(uint4*)(O + row * 1024 + col) = pack8(v0, v1); ); } };
struct EpiResidP { float* out; const float* x;
  EPI_HEAD_P { EPI_FOR8( const float* xp = x + row * 1024 + col; float* op = out + row * 1024 + col;
                         const f32x4 r0 = *(const f32x4*)xp + v0, r1 = *(const f32x4*)(xp + 4) + v1; *(f32x4*)op = r0; *(f32x4*)(op + 4) = r1; ); } };
struct EpiPle2P { float* out; const u16* PE;
  EPI_HEAD_P { EPI_FOR8T( float pe[8]; unpack8(*(const uint4*)(PE + row * 1024 + col), pe); float* op = out + row * 1024 + col; f32x4 a, b;
                         a[0] = pe[0] * sigmoidf(v0[0]); a[1] = pe[1] * sigmoidf(v0[1]); a[2] = pe[2] * sigmoidf(v0[2]); a[3] = pe[3] * sigmoidf(v0[3]);
                         b[0] = pe[4] * sigmoidf(v1[0]); b[1] = pe[5] * sigmoidf(v1[1]); b[2] = pe[6] * sigmoidf(v1[2]); b[3] = pe[7] * sigmoidf(v1[3]);
                         *(f32x4*)op = *(const f32x4*)op + a; *(f32x4*)(op + 4) = *(const f32x4*)(op + 4) + b; ); } };
struct EpiProj { u16 *Q, *Kb, *VT, *ZR, *GT;
  EPI_HEAD {
    if (u.pn < 2) { EPI_FOR( *(uint2*)(Q + row * 512 + col) = pack4(v); ); }
    else if (u.pn == 2) {
      EPI_FOR( if (bj == 0) { *(uint2*)(Kb + row * 128 + (col - 512)) = pack4(v); }
               else { const int c = col - 640, kvh = c >> 6, d = c & 63, b = (int)(row >> 12), s = (int)(row & 4095);
                      u16* vp = VT + ((size_t)((b * 2 + kvh) * 64 + d)) * 4096 + s; const uint2 pk = pack4(v);
                      vp[0] = (u16)(pk.x & 0xffffu); vp[4096] = (u16)(pk.x >> 16); vp[8192] = (u16)(pk.y & 0xffffu); vp[12288] = (u16)(pk.y >> 16); } );
    }
    else if (u.pn < 10) { EPI_FOR( *(uint2*)(ZR + row * 1792 + (col - 768)) = pack4(v); ); }
    else { EPI_FOR( f32x4 sgm; sgm[0] = sigmoidf(v[0]); sgm[1] = sigmoidf(v[1]); sgm[2] = sigmoidf(v[2]); sgm[3] = sigmoidf(v[3]);
                    *(uint2*)(GT + row * 2048 + (col - 2560)) = pack4(sgm); ); }
  } };
struct EpiMerge1 { u16* MG; const u16* GT;
  EPI_HEAD { EPI_FOR( const uint2 g = *(const uint2*)(GT + row * 2048 + col); f32x4 o;
                      o[0] = v[0] * bflo(g.x); o[1] = v[1] * bfhi(g.x); o[2] = v[2] * bflo(g.y); o[3] = v[3] * bfhi(g.y);
                      *(uint2*)(MG + row * 1024 + col) = pack4(o); ); } };
struct EpiMerge2 { u16* MG; const u16* GT;
  EPI_HEAD { EPI_FOR( const uint2 g = *(const uint2*)(GT + row * 2048 + 1024 + col); const uint2 p = *(const uint2*)(MG + row * 1024 + col); f32x4 o;
                      o[0] = bflo(p.x) + v[0] * bflo(g.x); o[1] = bfhi(p.x) + v[1] * bfhi(g.x); o[2] = bflo(p.y) + v[2] * bflo(g.y); o[3] = bfhi(p.y) + v[3] * bfhi(g.y);
                      *(uint2*)(MG + row * 1024 + col) = pack4(o); ); } };
struct EpiMergeCat { u16* MG; const u16* GT;
  static constexpr bool PERM = false, AFTER_DRAIN = false;
  DI void mid(f32x4 (&acc)[2][2][4][2], const Unit& u, int wr, int wc, int fr, int fq) const {
    const int row0_ = u.pm * 256 + wr * 64 + fr, col0_ = u.pn * 256 + wc * 32 + 4 * fq;
#pragma unroll
    for (int ai = 0; ai < 2; ++ai)
#pragma unroll
      for (int m = 0; m < 4; ++m) {
        const size_t row = (size_t)(row0_ + ai * 128 + m * 16);
#pragma unroll
        for (int bj = 0; bj < 2; ++bj)
#pragma unroll
          for (int n = 0; n < 2; ++n) {
            const int col = col0_ + bj * 128 + n * 16;
            const uint2 g0 = *(const uint2*)(GT + row * 2048 + col), g1 = *(const uint2*)(GT + row * 2048 + 1024 + col);
            acc[ai][bj][m][n][0] *= bflo(g0.x) * __builtin_amdgcn_rcpf(vmax_raw(bflo(g1.x), 1e-20f));
            acc[ai][bj][m][n][1] *= bfhi(g0.x) * __builtin_amdgcn_rcpf(vmax_raw(bfhi(g1.x), 1e-20f));
            acc[ai][bj][m][n][2] *= bflo(g0.y) * __builtin_amdgcn_rcpf(vmax_raw(bflo(g1.y), 1e-20f));
            acc[ai][bj][m][n][3] *= bfhi(g0.y) * __builtin_amdgcn_rcpf(vmax_raw(bfhi(g1.y), 1e-20f));
          }
        if (m & 1) asm volatile("" ::: "memory");
      }
  }
  DI void operator()(const f32x4 (&acc)[2][2][4][2], const Unit& u, int wr, int wc, int fr, int fq) const {
    EPI_FOR( const uint2 g1 = *(const uint2*)(GT + row * 2048 + 1024 + col); f32x4 o;
             o[0] = v[0] * vmax_raw(bflo(g1.x), 1e-20f); o[1] = v[1] * vmax_raw(bfhi(g1.x), 1e-20f); o[2] = v[2] * vmax_raw(bflo(g1.y), 1e-20f); o[3] = v[3] * vmax_raw(bfhi(g1.y), 1e-20f);
             *(uint2*)(MG + row * 1024 + col) = pack4(o); );
  } };
struct EpiResid { float* out; const float* x;
  EPI_HEAD { EPI_FOR( *(f32x4*)(out + row * 1024 + col) = *(const f32x4*)(x + row * 1024 + col) + v; ); } };
struct EpiRelu2 { u16* HID;
  EPI_HEAD { EPI_FOR( f32x4 o; o[0] = fmaxf(v[0], 0.f); o[1] = fmaxf(v[1], 0.f); o[2] = fmaxf(v[2], 0.f); o[3] = fmaxf(v[3], 0.f); o = o * o;
                      *(uint2*)(HID + row * 4096 + col) = pack4(o); ); } };
struct EpiStoreBf { u16* O;
  EPI_HEAD { EPI_FOR( *(uint2*)(O + row * 1024 + col) = pack4(v); ); } };
struct EpiPle2 { float* out; const u16* PE;
  EPI_HEAD { EPI_FOR( const uint2 p = *(const uint2*)(PE + row * 1024 + col); f32x4 o;
                      o[0] = bflo(p.x) * sigmoidf(v[0]); o[1] = bfhi(p.x) * sigmoidf(v[1]); o[2] = bflo(p.y) * sigmoidf(v[2]); o[3] = bfhi(p.y) * sigmoidf(v[3]);
                      float* op = out + row * 1024 + col; *(f32x4*)op = *(const f32x4*)op + o; ); } };

template <class Epi> DI void run_gemm(char* smem, const u16* A, const u16* Bt, int N, int K, const Epi& E) {
  pg8::StaticOrder S; S.init(T, N, gridDim.x, blockIdx.x);
  pg8::Gemm g{A, Bt, T, N, K};
  pg8::gemm_phase<Epi, pg8::StaticOrder, false>((PG8_LAS unsigned char*)smem, g, S, E, nullptr);
}

template <class Epi> DI void run_gemm_cat(char* smem, const u16* A1, const u16* B1, const u16* A2, const u16* B2, int N, int K, const Epi& E) {
  pg8::StaticOrder S; S.init(T, N, gridDim.x, blockIdx.x);
  pg8::Gemm g{A1, B1, T, N, K};
  pg8::gemm_phase_cat<Epi, pg8::StaticOrder, false>((PG8_LAS unsigned char*)smem, g, A2, B2, S, E, nullptr);
}

DI void p1_proj(const Params& P, char* smem) {
  EpiProjP E{(u16*)(P.ws + QKV_OFF), (u16*)(P.ws + K_OFF), (u16*)(P.ws + VT_OFF), (u16*)(P.ws + ZR_OFF), (u16*)(P.ws + GATES_OFF)};
  run_gemm(smem, (const u16*)P.out, (const u16*)P.ws + WT_IN, 4608, 1024, E);
}

#define MFMA16(a, b, c) __builtin_amdgcn_mfma_f32_16x16x32_bf16((a), (b), (c), 0, 0, 0)
constexpr int LDT = 72;
DI void norm_row_to_lds(const u16* srow, bool valid, const float* gain, const float* ROT, int pos, float scale, u16* drow, int quarter) {
  uint4 o0 = make_uint4(0u, 0u, 0u, 0u), o1 = o0;
  uint4 a0 = o0, a1 = o0;
  if (valid) { a0 = *(const uint4*)(srow + quarter * 16); a1 = *(const uint4*)(srow + quarter * 16 + 8); }
  unsigned uu[8] = {a0.x, a0.y, a0.z, a0.w, a1.x, a1.y, a1.z, a1.w};
  float x[16]; float ss = 0.f;
#pragma unroll
  for (int e = 0; e < 8; ++e) { x[2 * e] = __uint_as_float(uu[e] << 16); x[2 * e + 1] = __uint_as_float(uu[e] & 0xffff0000u); ss += x[2 * e] * x[2 * e] + x[2 * e + 1] * x[2 * e + 1]; }
  ss += __shfl_xor(ss, 1); ss += __shfl_xor(ss, 2);
  const float sc = rsqrtf(ss * (1.f / 64.f) + 1e-6f);
  const float4* g4 = (const float4*)(gain + quarter * 16);
#pragma unroll
  for (int e = 0; e < 4; ++e) { float4 g = g4[e]; x[4 * e] *= sc * g.x; x[4 * e + 1] *= sc * g.y; x[4 * e + 2] *= sc * g.z; x[4 * e + 3] *= sc * g.w; }
  if (quarter == 0 && valid) {
    const float4* c4 = (const float4*)(ROT + pos * 8); const float4* s4 = (const float4*)(ROT + 32768 + pos * 8);
    float4 ca = c4[0], cb = c4[1], sa = s4[0], sb = s4[1];
    float cs[8] = {ca.x, ca.y, ca.z, ca.w, cb.x, cb.y, cb.z, cb.w}, sn[8] = {sa.x, sa.y, sa.z, sa.w, sb.x, sb.y, sb.z, sb.w};
#pragma unroll
    for (int e = 0; e < 8; ++e) { float x1 = x[e], x2 = x[e + 8]; x[e] = x1 * cs[e] - x2 * sn[e]; x[e + 8] = x2 * cs[e] + x1 * sn[e]; }
  }
  if (valid) {
    o0 = make_uint4(pack2(x[0] * scale, x[1] * scale), pack2(x[2] * scale, x[3] * scale), pack2(x[4] * scale, x[5] * scale), pack2(x[6] * scale, x[7] * scale));
    o1 = make_uint4(pack2(x[8] * scale, x[9] * scale), pack2(x[10] * scale, x[11] * scale), pack2(x[12] * scale, x[13] * scale), pack2(x[14] * scale, x[15] * scale));
  }
  *(uint4*)(drow + quarter * 16) = o0; *(uint4*)(drow + quarter * 16 + 8) = o1;
}

constexpr int VTS = 392;
DI void p2_attn(const Params& P, char* smem) {
  const int tid = tid_fresh(), lane = tid & 63, w = tid >> 6;
  u16* Ks = (u16*)smem;
  u16* Vt = Ks + 384 * LDT;
  u16* Qs = Vt + 64 * VTS;
  const u16* Q = (const u16*)(P.ws + QKV_OFF); const u16* Kb = (const u16*)(P.ws + K_OFF); const u16* VT = (const u16*)(P.ws + VT_OFF);
  const float* ROT = (const float*)(P.ws + ROT_OFF);
  u16* AT = (u16*)(P.ws + ATTN_OFF);
  const int fr = lane & 15, fg = lane >> 4;
  for (int bi = blockIdx.x; bi < 256; bi += gridDim.x) {
    const int kvh = bi & 1, qblk = (bi >> 1) & 31, b = bi >> 6;
    const int kbase = qblk * 128 - 128;
#pragma unroll 1
    for (int ps = 0; ps < 3; ++ps) {
      const int rowl = ps * 128 + (tid >> 2), kp = kbase + rowl;
      const bool valid = kp >= 0 && kp < S;
      norm_row_to_lds(Kb + (size_t)(b * S + (valid ? kp : 0)) * 128 + kvh * 64, valid, P.k_norm, ROT, kp, 1.0f, Ks + rowl * LDT, tid & 3);
    }
#pragma unroll 2
    for (int i = 0; i < 6; ++i) {
      const int c = i * NTHR + tid, key = c % 384, dq = (c / 384) * 8, kp = kbase + key;
      uint4 v = make_uint4(0u, 0u, 0u, 0u);
      if (kp >= 0 && kp < S) v = *(const uint4*)(VT + (size_t)(b * S + kp) * 128 + kvh * 64 + dq);
      u16* vp = Vt + dq * VTS + key;
      vp[0] = (u16)(v.x & 0xffffu); vp[VTS] = (u16)(v.x >> 16); vp[2 * VTS] = (u16)(v.y & 0xffffu); vp[3 * VTS] = (u16)(v.y >> 16);
      vp[4 * VTS] = (u16)(v.z & 0xffffu); vp[5 * VTS] = (u16)(v.z >> 16); vp[6 * VTS] = (u16)(v.w & 0xffffu); vp[7 * VTS] = (u16)(v.w >> 16);
    }
#pragma unroll 1
    for (int g = 0; g < 4; ++g) {
      const int qh = kvh * 4 + g;
      {
        const int rowl = tid >> 2, qp = qblk * 128 + rowl;
        norm_row_to_lds(Q + (size_t)(b * S + qp) * 512 + qh * 64, true, P.q_norm, ROT, qp, 0.125f * 1.44269504f, Qs + rowl * LDT, tid & 3);
      }
      __syncthreads();
      const int qw = w * 16;
      bf16x8 bq0 = *(const bf16x8*)(Qs + (qw + fr) * LDT + fg * 8);
      bf16x8 bq1 = *(const bf16x8*)(Qs + (qw + fr) * LDT + 32 + fg * 8);
      f32x4 st[17];
#pragma unroll
      for (int i = 0; i < 17; ++i) {
        const bf16x8 ak0 = *(const bf16x8*)(Ks + ((w + i) * 16 + fr) * LDT + fg * 8);
        const bf16x8 ak1 = *(const bf16x8*)(Ks + ((w + i) * 16 + fr) * LDT + 32 + fg * 8);
        f32x4 z = {0.f, 0.f, 0.f, 0.f};
        z = MFMA16(ak0, bq0, z);
        st[i] = MFMA16(ak1, bq1, z);
        if ((i & 3) == 3) __builtin_amdgcn_sched_barrier(0);
      }
#pragma unroll
      for (int r = 0; r < 4; ++r) {
        st[0][r] = (fg * 4 + r >= fr) ? st[0][r] : -1e30f;
        st[16][r] = (fg * 4 + r <= fr) ? st[16][r] : -1e30f;
      }
      if (qblk == 0 || qblk == 31) {
#pragma unroll
        for (int i = 0; i < 17; ++i) {
          const int kt = w + i;
          const float pen = ((qblk == 0 && kt < 8) || (qblk == 31 && kt >= 16)) ? -1e30f : 0.f;
#pragma unroll
          for (int r = 0; r < 4; ++r) st[i][r] += pen;
        }
      }
      float m = -1e30f;
#pragma unroll
      for (int i = 0; i < 17; ++i) { m = vmax3_raw(m, st[i][0], st[i][1]); m = vmax3_raw(m, st[i][2], st[i][3]); }
      m = vmax_raw(m, __shfl_xor(m, 16)); m = vmax_raw(m, __shfl_xor(m, 32));
      const float sk = P.sink[qh] * 1.44269504f;
      m = fmaxf(m, sk);
      float l = 0.f;
#pragma unroll
      for (int i = 0; i < 17; ++i)
#pragma unroll
        for (int r = 0; r < 4; ++r) {
          const float pv = __builtin_amdgcn_exp2f(st[i][r] - m);
          st[i][r] = pv; l += pv;
        }
      l += __shfl_xor(l, 16); l += __shfl_xor(l, 32);
      l += __builtin_amdgcn_exp2f(sk - m);
      const float invl = __builtin_amdgcn_rcpf(l);
      f32x4 ot[4];
#pragma unroll
      for (int dt = 0; dt < 4; ++dt) ot[dt] = f32x4{0.f, 0.f, 0.f, 0.f};
#pragma unroll
      for (int c = 0; c < 9; ++c) {
        union { unsigned u[4]; bf16x8 v; } pb;
        pb.u[0] = pack2(st[2 * c][0], st[2 * c][1]); pb.u[1] = pack2(st[2 * c][2], st[2 * c][3]);
        if (c < 8) { pb.u[2] = pack2(st[2 * c + 1][0], st[2 * c + 1][1]); pb.u[3] = pack2(st[2 * c + 1][2], st[2 * c + 1][3]); }
        else { pb.u[2] = 0u; pb.u[3] = 0u; }
        const int k0 = (w + 2 * c) * 16 + fg * 4, k1 = min(w + 2 * c + 1, 23) * 16 + fg * 4;
#pragma unroll
        for (int dt = 0; dt < 4; ++dt) {
          union { uint2 h[2]; bf16x8 v; } av;
          const int vrow = 32 * (dt >> 1) + 8 * (fr >> 2) + 4 * (dt & 1) + (fr & 3);
          av.h[0] = *(const uint2*)(Vt + vrow * VTS + k0);
          av.h[1] = *(const uint2*)(Vt + vrow * VTS + k1);
          ot[dt] = MFMA16(av.v, pb.v, ot[dt]);
        }
        __builtin_amdgcn_sched_barrier(0);
      }
      const size_t tok = (size_t)(b * S + qblk * 128 + qw + fr);
#pragma unroll
      for (int g2 = 0; g2 < 2; ++g2) {
        uint4 o;
        o.x = pack2(ot[2 * g2][0] * invl, ot[2 * g2][1] * invl); o.y = pack2(ot[2 * g2][2] * invl, ot[2 * g2][3] * invl);
        o.z = pack2(ot[2 * g2 + 1][0] * invl, ot[2 * g2 + 1][1] * invl); o.w = pack2(ot[2 * g2 + 1][2] * invl, ot[2 * g2 + 1][3] * invl);
        *(uint4*)(AT + tok * 512 + qh * 64 + g2 * 32 + fg * 8) = o;
      }
      __syncthreads();
    }
  }
}

template <int MODE>
DI void stage_shift128(const u16* ZR, const float* shift_mu, int t0, int zc0, u16* dst, int ldr) {
  const int tid = tid_fresh(), tt = tid >> 3, cg = (tid & 7) * 16, t = t0 + tt, s = t & 4095;
  const u16* zp = ZR + (size_t)t * 1792 + zc0 + cg;
  uint4 c0 = *(const uint4*)zp, c1 = *(const uint4*)(zp + 8), p0 = make_uint4(0u, 0u, 0u, 0u), p1 = p0, n0 = p0, n1 = p0;
  if (s > 0) { p0 = *(const uint4*)(zp - 1792); p1 = *(const uint4*)(zp - 1792 + 8); }
  if (s < S - 1) { n0 = *(const uint4*)(zp + 1792); n1 = *(const uint4*)(zp + 1792 + 8); }
  const unsigned cw[8] = {c0.x, c0.y, c0.z, c0.w, c1.x, c1.y, c1.z, c1.w}, pw[8] = {p0.x, p0.y, p0.z, p0.w, p1.x, p1.y, p1.z, p1.w},
                 nw[8] = {n0.x, n0.y, n0.z, n0.w, n1.x, n1.y, n1.z, n1.w};
  const float4* mu4 = (const float4*)(shift_mu + zc0 + cg);
  unsigned ow[8];
#pragma unroll
  for (int q = 0; q < 4; ++q) {
    const float4 mu = mu4[q];
    float val[4];
#pragma unroll
    for (int e = 0; e < 4; ++e) {
      const int wi = q * 2 + (e >> 1);
      const float z = (e & 1) ? bfhi(cw[wi]) : bflo(cw[wi]), pv = (e & 1) ? bfhi(pw[wi]) : bflo(pw[wi]), nx = (e & 1) ? bfhi(nw[wi]) : bflo(nw[wi]);
      const float m_ = e == 0 ? mu.x : e == 1 ? mu.y : e == 2 ? mu.z : mu.w;
      float x = z + m_ * (0.5f * (pv + nx) - z);
      if (MODE == 1) x = sigmoidf(x);
      else if (cg < 64) { const float e2 = __expf(2.f * x); x = 1.f - 2.f * __builtin_amdgcn_rcpf(e2 + 1.f); }
      val[e] = x;
    }
    ow[q * 2] = pack2(val[0], val[1]); ow[q * 2 + 1] = pack2(val[2], val[3]);
  }
  *(uint4*)(dst + tt * ldr + cg) = make_uint4(ow[0], ow[1], ow[2], ow[3]);
  *(uint4*)(dst + tt * ldr + cg + 8) = make_uint4(ow[4], ow[5], ow[6], ow[7]);
}
DI bf16x8 bfrag_from_f32(const float* Wm, int k0, int c) {
  union { unsigned u[4]; bf16x8 v; } r;
#pragma unroll
  for (int j = 0; j < 4; ++j) r.u[j] = pack2(Wm[(size_t)(k0 + 2 * j) * 512 + c], Wm[(size_t)(k0 + 2 * j + 1) * 512 + c]);
  return r.v;
}
DI void p2_prep(const Params& P, char* smem) {
  const int tid = tid_fresh(), lane = tid & 63, w = tid >> 6, fr = lane & 15, fq = lane >> 4;
  u16* As = (u16*)smem;
  const u16* ZR = (const u16*)(P.ws + ZR_OFF);
  u16* SW = (u16*)P.out; u16* AA = SW + (size_t)2 * T * 512;
  const int c0 = w * 64;
  for (int tile = blockIdx.x; tile < T / 64; tile += gridDim.x) {
    const int t0 = tile * 64;
    stage_shift128<0>(ZR, P.shift_mu, t0, 1536, As, 136);
    __syncthreads();
#pragma unroll 1
    for (int mat = 0; mat < 4; ++mat) {
      const int d = mat >> 1, isa = mat & 1;
      const u16* Wt = (const u16*)(P.ws + W2T_OFF) + (size_t)mat * 512 * 64;
      f32x4 acc[4][4];
#pragma unroll
      for (int m = 0; m < 4; ++m)
#pragma unroll
        for (int n = 0; n < 4; ++n) acc[m][n] = f32x4{0.f, 0.f, 0.f, 0.f};
#pragma unroll
      for (int ks = 0; ks < 2; ++ks) {
        bf16x8 bf[4], af[4];
#pragma unroll
        for (int n = 0; n < 4; ++n)
          bf[n] = *(const bf16x8*)(Wt + (size_t)(c0 + (n >> 1) * 32 + 8 * (fr >> 2) + 4 * (n & 1) + (fr & 3)) * 64 + ks * 32 + fq * 8);
#pragma unroll
        for (int m = 0; m < 4; ++m) af[m] = *(const bf16x8*)(As + (m * 16 + fr) * 136 + isa * 64 + ks * 32 + fq * 8);
#pragma unroll
        for (int m = 0; m < 4; ++m)
#pragma unroll
          for (int n = 0; n < 4; ++n) acc[m][n] = MFMA16(bf[n], af[m], acc[m][n]);
      }
      u16* O = (isa ? AA : SW) + (size_t)d * T * 512;
      const float* bias = (isa ? P.a0 : P.w0) + d * 512;
      const float mul = isa ? 1.f : 0.60653066f;
#pragma unroll
      for (int g = 0; g < 2; ++g) {
        const int c = c0 + g * 32 + 8 * fq;
        const float4 b0 = *(const float4*)(bias + c), b1 = *(const float4*)(bias + c + 4);
#pragma unroll
        for (int m = 0; m < 4; ++m) {
          f32x4 o0, o1;
          o0[0] = mul * sigmoidf(acc[m][2 * g][0] + b0.x); o0[1] = mul * sigmoidf(acc[m][2 * g][1] + b0.y);
          o0[2] = mul * sigmoidf(acc[m][2 * g][2] + b0.z); o0[3] = mul * sigmoidf(acc[m][2 * g][3] + b0.w);
          o1[0] = mul * sigmoidf(acc[m][2 * g + 1][0] + b1.x); o1[1] = mul * sigmoidf(acc[m][2 * g + 1][1] + b1.y);
          o1[2] = mul * sigmoidf(acc[m][2 * g + 1][2] + b1.z); o1[3] = mul * sigmoidf(acc[m][2 * g + 1][3] + b1.w);
          *(uint4*)(O + (size_t)(t0 + m * 16 + fr) * 512 + c) = pack8(o0, o1);
        }
      }
    }
    __syncthreads();
  }
}

constexpr int SCB = 5 * 2048 + 512 + 512;
struct ScanRaw { uint2 c[3], p[3], n[3], sw, aa; };
DI void scan_load(ScanRaw& R, const u16* ZR, const u16* SW, const u16* AA, int d, int b, int h, int ci, int pj, int pc) {
  const int step = ci * 32 + pj, s = d ? (S - 1 - step) : step, t = b * S + s;
  const u16* zp = ZR + (size_t)t * 1792 + h * 64 + pc;
#pragma unroll
  for (int g = 0; g < 3; ++g) {
    R.c[g] = *(const uint2*)(zp + g * 512);
    R.p[g] = s > 0 ? *(const uint2*)(zp + g * 512 - 1792) : make_uint2(0u, 0u);
    R.n[g] = s < S - 1 ? *(const uint2*)(zp + g * 512 + 1792) : make_uint2(0u, 0u);
  }
  R.sw = *(const uint2*)(SW + ((size_t)d * T + t) * 512 + h * 64 + pc);
  R.aa = *(const uint2*)(AA + ((size_t)d * T + t) * 512 + h * 64 + pc);
}
DI void scan_process(const ScanRaw& R, float* buf, int rq, int pj, int pc,
                     const float (&mur)[4], const float (&muk)[4], const float (&muv)[4], const float (&kkw)[4], const float (&kaw)[4]) {
  float rr[4], kk[4], vv[4];
#pragma unroll
  for (int g = 0; g < 3; ++g) {
    const unsigned cw[2] = {R.c[g].x, R.c[g].y}, pw[2] = {R.p[g].x, R.p[g].y}, nw2[2] = {R.n[g].x, R.n[g].y};
#pragma unroll
    for (int e = 0; e < 4; ++e) {
      const float z = (e & 1) ? bfhi(cw[e >> 1]) : bflo(cw[e >> 1]);
      const float pv = (e & 1) ? bfhi(pw[e >> 1]) : bflo(pw[e >> 1]);
      const float nx = (e & 1) ? bfhi(nw2[e >> 1]) : bflo(nw2[e >> 1]);
      const float mu = g == 0 ? mur[e] : g == 1 ? muk[e] : muv[e];
      const float val = z + mu * (0.5f * (pv + nx) - z);
      if (g == 0) rr[e] = val; else if (g == 1) kk[e] = val; else vv[e] = val;
    }
  }
  const unsigned sw2[2] = {R.sw.x, R.sw.y}, aw2[2] = {R.aa.x, R.aa.y};
  float kq[4], n2 = 0.f;
#pragma unroll
  for (int e = 0; e < 4; ++e) { kq[e] = kk[e] * kkw[e]; n2 += kq[e] * kq[e]; }
  n2 = row16_sum(n2);
  const float inv = fminf(__builtin_amdgcn_rsqf(n2), 1e12f);
  float tna[4], tw_[4], tb[4], tkd[4];
#pragma unroll
  for (int e = 0; e < 4; ++e) {
    const float sg = (e & 1) ? bfhi(sw2[e >> 1]) : bflo(sw2[e >> 1]);
    const float a = (e & 1) ? bfhi(aw2[e >> 1]) : bflo(aw2[e >> 1]);
    const float kn = kq[e] * inv;
    tna[e] = -kn; tw_[e] = __expf(-sg); tb[e] = kn * a; tkd[e] = kk[e] * (1.f + (a - 1.f) * kaw[e]);
  }
  float* NA = buf; float* Wd = NA + 2048; float* Bv = Wd + 2048; float* KD = Bv + 2048; float* Rr = KD + 2048; float* Vv = Rr + 2048;
  *(float4*)(NA + pj * 64 + pc) = make_float4(tna[0], tna[1], tna[2], tna[3]);
  *(float4*)(Wd + pj * 64 + pc) = make_float4(tw_[0], tw_[1], tw_[2], tw_[3]);
  *(float4*)(Bv + pj * 64 + pc) = make_float4(tb[0], tb[1], tb[2], tb[3]);
  *(float4*)(KD + pj * 64 + pc) = make_float4(tkd[0], tkd[1], tkd[2], tkd[3]);
  *(float4*)(Rr + pj * 64 + pc) = make_float4(rr[0], rr[1], rr[2], rr[3]);
  if ((pc >> 4) == rq) *(float4*)(Vv + pj * 16 + (pc & 15)) = make_float4(vv[0], vv[1], vv[2], vv[3]);
}
DI void p3_scan(const Params& P, char* smem) {
  const int tid = tid_fresh(), lane = tid & 63, w = tid >> 6;
  float* bufs = (float*)smem;
  const u16* ZR = (const u16*)(P.ws + ZR_OFF);
  const u16* SW = (const u16*)P.out; const u16* AA = SW + (size_t)2 * T * 512;
  u16* Y = (u16*)(P.ws + Y_OFF);
  for (int item = blockIdx.x; item < 256; item += gridDim.x) {
    const int u = (item & 7) * 8 + (item >> 5), rq = (item >> 3) & 3;
    const int d = u >> 5, b = (u >> 3) & 3, h = u & 7;
    if (w >= 4) {
      const int lt = tid & 255, pj = lt >> 4, pc = (lt & 15) * 4;
      float mur[4], muk[4], muv[4], kkw[4], kaw[4];
#pragma unroll
      for (int e = 0; e < 4; ++e) {
        mur[e] = P.shift_mu[h * 64 + pc + e]; muk[e] = P.shift_mu[512 + h * 64 + pc + e]; muv[e] = P.shift_mu[1024 + h * 64 + pc + e];
        kkw[e] = P.k_k[h * 64 + pc + e]; kaw[e] = P.k_a[h * 64 + pc + e];
      }
      ScanRaw r0, r1;
      scan_load(r0, ZR, SW, AA, d, b, h, 0, pj, pc); scan_load(r1, ZR, SW, AA, d, b, h, 0, pj + 16, pc);
      scan_process(r0, bufs, rq, pj, pc, mur, muk, muv, kkw, kaw); scan_process(r1, bufs, rq, pj + 16, pc, mur, muk, muv, kkw, kaw);
      scan_load(r0, ZR, SW, AA, d, b, h, 1, pj, pc); scan_load(r1, ZR, SW, AA, d, b, h, 1, pj + 16, pc);
      __syncthreads();
      for (int ci = 0; ci < 128; ++ci) {
        if (ci + 1 < 128) {
          float* nxt = bufs + ((ci + 1) & 1) * SCB;
          scan_process(r0, nxt, rq, pj, pc, mur, muk, muv, kkw, kaw); scan_process(r1, nxt, rq, pj + 16, pc, mur, muk, muv, kkw, kaw);
          if (ci + 2 < 128) { scan_load(r0, ZR, SW, AA, d, b, h, ci + 2, pj, pc); scan_load(r1, ZR, SW, AA, d, b, h, ci + 2, pj + 16, pc); }
        }
        if (ci > 0) {
          const float* YSp = bufs + ((ci - 1) & 1) * SCB + 5 * 2048 + 512;
          if (lt < 64) {
            const int step = (ci - 1) * 32 + (lt >> 1), s = d ? (S - 1 - step) : step, t = b * S + s;
            const float4 ya = *(const float4*)(YSp + lt * 8), yb = *(const float4*)(YSp + lt * 8 + 4);
            *(uint4*)(Y + ((size_t)d * T + t) * 512 + h * 64 + rq * 16 + (lt & 1) * 8) = make_uint4(pack2(ya.x, ya.y), pack2(ya.z, ya.w), pack2(yb.x, yb.y), pack2(yb.z, yb.w));
          }
        }
        __syncthreads();
      }
      {
        const float* YSp = bufs + (127 & 1) * SCB + 5 * 2048 + 512;
        if (lt < 64) {
          const int step = 127 * 32 + (lt >> 1), s = d ? (S - 1 - step) : step, t = b * S + s;
          const float4 ya = *(const float4*)(YSp + lt * 8), yb = *(const float4*)(YSp + lt * 8 + 4);
          *(uint4*)(Y + ((size_t)d * T + t) * 512 + h * 64 + rq * 16 + (lt & 1) * 8) = make_uint4(pack2(ya.x, ya.y), pack2(ya.z, ya.w), pack2(yb.x, yb.y), pack2(yb.z, yb.w));
        }
      }
    } else {
      __builtin_amdgcn_s_setprio(2);
      const int rl = w * 4 + (lane >> 4), jl = lane & 15;
      f32x2v sA = {0.f, 0.f}, sB = {0.f, 0.f};
      __syncthreads();
      for (int ci = 0; ci < 128; ++ci) {
        const float* cur = bufs + (ci & 1) * SCB;
        const float* NA = cur + jl * 4; const float* Vv = cur + 5 * 2048 + rl;
        float yk0 = 0.f, yk1 = 0.f;
        float4 qna[3], qw[3], qb[3], qk[3], qr[3]; float qv[3];
#pragma unroll
        for (int p = 0; p < 2; ++p) {
          qna[p] = *(const float4*)(NA + p * 64); qw[p] = *(const float4*)(NA + 2048 + p * 64); qb[p] = *(const float4*)(NA + 4096 + p * 64);
          qk[p] = *(const float4*)(NA + 6144 + p * 64); qr[p] = *(const float4*)(NA + 8192 + p * 64); qv[p] = Vv[p * 16];
        }
#pragma unroll
        for (int j = 0; j < 32; ++j) {
          if (j + 2 < 32) {
            const int sn = (j + 2) % 3;
            qna[sn] = *(const float4*)(NA + (j + 2) * 64); qw[sn] = *(const float4*)(NA + 2048 + (j + 2) * 64); qb[sn] = *(const float4*)(NA + 4096 + (j + 2) * 64);
            qk[sn] = *(const float4*)(NA + 6144 + (j + 2) * 64); qr[sn] = *(const float4*)(NA + 8192 + (j + 2) * 64); qv[sn] = Vv[(j + 2) * 16];
          }
          __builtin_amdgcn_sched_barrier(7);
          const int sl = j % 3;
          const float4 na = qna[sl], wv = qw[sl], bv = qb[sl], kd = qk[sl], rv = qr[sl]; const float v = qv[sl];
          const f32x2v naA = {na.x, na.y}, naB = {na.z, na.w}, wA = {wv.x, wv.y}, wB = {wv.z, wv.w}, bA = {bv.x, bv.y}, bB = {bv.z, bv.w};
          const f32x2v kA = {kd.x, kd.y}, kB = {kd.z, kd.w}, rA = {rv.x, rv.y}, rB = {rv.z, rv.w};
          const f32x2v pp = sA * naA + sB * naB;
          float pa = pp.x + pp.y;
          const f32x2v vv2 = {v, v};
          const f32x2v uA = sA * wA + vv2 * kA, uB = sB * wB + vv2 * kB;
          pa = row16_sum(pa);
          asm volatile("" : "+v"(pa));
          const f32x2v pav = {pa, pa};
          sA = pav * bA + uA; sB = pav * bB + uB;
          const f32x2v qq = sA * rA + sB * rB;
          const float py = row16_sum(qq.x + qq.y);
          if (j < 16) yk0 = (jl == j) ? py : yk0; else yk1 = (jl == j - 16) ? py : yk1;
        }
        float* YS = bufs + (ci & 1) * SCB + 5 * 2048 + 512;
        YS[jl * 16 + rl] = yk0; YS[(16 + jl) * 16 + rl] = yk1;
        __syncthreads();
      }
      __builtin_amdgcn_s_setprio(0);
    }
    __syncthreads();
  }
}

DI float4 shift4(const u16* zp, int s, const float4 mu) {
  const uint2 c = *(const uint2*)zp;
  uint2 p = make_uint2(0u, 0u), n = p;
  if (s > 0) p = *(const uint2*)(zp - 1792);
  if (s < S - 1) n = *(const uint2*)(zp + 1792);
  float4 o;
  { const float z = bflo(c.x); o.x = z + mu.x * (0.5f * (bflo(p.x) + bflo(n.x)) - z); }
  { const float z = bfhi(c.x); o.y = z + mu.y * (0.5f * (bfhi(p.x) + bfhi(n.x)) - z); }
  { const float z = bflo(c.y); o.z = z + mu.z * (0.5f * (bflo(p.y) + bflo(n.y)) - z); }
  { const float z = bfhi(c.y); o.w = z + mu.w * (0.5f * (bfhi(p.y) + bfhi(n.y)) - z); }
  return o;
}
DI void shift8_dpp(const u16* zp, int s, int fr, const float* mu, float (&o)[8]) {
  const uint4 c = *(const uint4*)zp;
  uint4 pe = make_uint4(0u, 0u, 0u, 0u), ne = pe;
  if (fr == 0 && s > 0) pe = *(const uint4*)(zp - 1792);
  if (fr == 15 && s < S - 1) ne = *(const uint4*)(zp + 1792);
  const unsigned cw[4] = {c.x, c.y, c.z, c.w}, pw[4] = {pe.x, pe.y, pe.z, pe.w}, nw[4] = {ne.x, ne.y, ne.z, ne.w};
  const float4 m0 = *(const float4*)mu, m1 = *(const float4*)(mu + 4);
  const float mm[8] = {m0.x, m0.y, m0.z, m0.w, m1.x, m1.y, m1.z, m1.w};
#pragma unroll
  for (int q = 0; q < 4; ++q) {
    const unsigned p = (unsigned)__builtin_amdgcn_update_dpp((int)pw[q], (int)cw[q], 0x111, 0xF, 0xF, false);
    const unsigned n = (unsigned)__builtin_amdgcn_update_dpp((int)nw[q], (int)cw[q], 0x101, 0xF, 0xF, false);
    { const float z = bflo(cw[q]); o[2 * q] = z + mm[2 * q] * (0.5f * (bflo(p) + bflo(n)) - z); }
    { const float z = bfhi(cw[q]); o[2 * q + 1] = z + mm[2 * q + 1] * (0.5f * (bfhi(p) + bfhi(n)) - z); }
  }
}
DI void ld8(const float* p, float (&o)[8]) { const float4 a = *(const float4*)p, b = *(const float4*)(p + 4); o[0] = a.x; o[1] = a.y; o[2] = a.z; o[3] = a.w; o[4] = b.x; o[5] = b.y; o[6] = b.z; o[7] = b.w; }
DI void final_rows(const float* PT, const u16* ZR, const u16* AA, const u16* Y, u16* RW, const u16* grow, int t, int c0, int fq, int fr) {
  const int s = t & 4095;
  int cb = c0 + 8 * fq;
  asm volatile("" : "+v"(cb));
  float yv[2][8], vv[2][8];
  float sy = 0.f, sb = 0.f;
#pragma unroll
  for (int g = 0; g < 2; ++g) {
    const int c = cb + g * 32;
    float y0[8], y1[8];
    unpack8(*(const uint4*)(Y + (size_t)t * 512 + c), y0); unpack8(*(const uint4*)(Y + ((size_t)T + t) * 512 + c), y1);
    const u16* zp = ZR + (size_t)t * 1792 + c;
    float r[8], k[8];
    shift8_dpp(zp, s, fr, PT + c, r); shift8_dpp(zp + 512, s, fr, PT + 512 + c, k); shift8_dpp(zp + 1024, s, fr, PT + 1024 + c, vv[g]);
    float a0[8], a1[8], ka[8], rk0[8], rk1[8];
    unpack8(*(const uint4*)(AA + (size_t)t * 512 + c), a0); unpack8(*(const uint4*)(AA + ((size_t)T + t) * 512 + c), a1);
    ld8(PT + 1536 + c, ka); ld8(PT + 2048 + c, rk0); ld8(PT + 2560 + c, rk1);
#pragma unroll
    for (int e = 0; e < 8; ++e) {
      yv[g][e] = y0[e] + y1[e]; sy += yv[g][e];
      sb += r[e] * k[e] * ((1.f + (a0[e] - 1.f) * ka[e]) * rk0[e] + (1.f + (a1[e] - 1.f) * ka[e]) * rk1[e]);
    }
  }
  sy += __shfl_xor(sy, 16); sy += __shfl_xor(sy, 32);
  sb += __shfl_xor(sb, 16); sb += __shfl_xor(sb, 32);
  const float mu = sy * (1.f / 64.f);
  float sv = 0.f;
#pragma unroll
  for (int g = 0; g < 2; ++g)
#pragma unroll
    for (int e = 0; e < 8; ++e) { yv[g][e] -= mu; sv += yv[g][e] * yv[g][e]; }
  sv += __shfl_xor(sv, 16); sv += __shfl_xor(sv, 32);
  const float rstd = rsqrtf(sv * (1.f / 64.f) + 64e-5f);
#pragma unroll
  for (int g = 0; g < 2; ++g) {
    const int c = cb + g * 32;
    float lw[8], lb[8], gg[8];
    ld8(PT + 3072 + c, lw); ld8(PT + 3584 + c, lb); unpack8(*(const uint4*)(grow + g * 32), gg);
    f32x4 o0, o1;
#pragma unroll
    for (int e = 0; e < 4; ++e) {
      o0[e] = (yv[g][e] * rstd * lw[e] + lb[e] + sb * vv[g][e]) * gg[e];
      o1[e] = (yv[g][4 + e] * rstd * lw[4 + e] + lb[4 + e] + sb * vv[g][4 + e]) * gg[4 + e];
    }
    *(uint4*)(RW + (size_t)t * 512 + c) = pack8(o0, o1);
  }
  __builtin_amdgcn_sched_barrier(0);
}
DI void p4_final(const Params& P, char* smem) {
  const int tid = tid_fresh(), lane = tid & 63, w = tid >> 6, fr = lane & 15, fq = lane >> 4;
  u16* As = (u16*)smem;
  u16* Gs = As + 64 * 136;
  float* PT = (float*)(smem + 83968);
  const u16* ZR = (const u16*)(P.ws + ZR_OFF);
  const u16* AA = (const u16*)P.out + (size_t)2 * T * 512;
  const u16* Y = (const u16*)(P.ws + Y_OFF);
  u16* RW = (u16*)(P.ws + RW_OFF);
  const int c0 = w * 64;
  PT[tid] = P.shift_mu[tid]; PT[512 + tid] = P.shift_mu[512 + tid]; PT[1024 + tid] = P.shift_mu[1024 + tid]; PT[1536 + tid] = P.k_a[tid];
  PT[2048 + tid] = P.r_k[tid]; PT[2560 + tid] = P.r_k[512 + tid]; PT[3072 + tid] = P.lnx_w[tid]; PT[3584 + tid] = P.lnx_b[tid];
  for (int tile = blockIdx.x; tile < T / 64; tile += gridDim.x) {
    const int t0 = tile * 64;
    stage_shift128<1>(ZR, P.shift_mu, t0, 1664, As, 136);
    __syncthreads();
#pragma unroll 1
    for (int nh = 0; nh < 2; ++nh) {
      f32x4 acc[4][2];
#pragma unroll
      for (int m = 0; m < 4; ++m)
#pragma unroll
        for (int n = 0; n < 2; ++n) acc[m][n] = f32x4{0.f, 0.f, 0.f, 0.f};
#pragma unroll
      for (int ks = 0; ks < 4; ++ks) {
        bf16x8 bf[2], af[4];
#pragma unroll
        for (int n = 0; n < 2; ++n) bf[n] = *(const bf16x8*)((const u16*)(P.ws + G2T_OFF) + (size_t)(c0 + nh * 32 + 8 * (fr >> 2) + 4 * n + (fr & 3)) * 128 + ks * 32 + fq * 8);
#pragma unroll
        for (int m = 0; m < 4; ++m) af[m] = *(const bf16x8*)(As + (m * 16 + fr) * 136 + ks * 32 + fq * 8);
#pragma unroll
        for (int m = 0; m < 4; ++m)
#pragma unroll
          for (int n = 0; n < 2; ++n) acc[m][n] = MFMA16(bf[n], af[m], acc[m][n]);
        __builtin_amdgcn_sched_barrier(0);
      }
#pragma unroll
      for (int m = 0; m < 4; ++m) *(uint4*)(Gs + (m * 16 + fr) * 520 + c0 + nh * 32 + 8 * fq) = pack8(acc[m][0], acc[m][1]);
    }
#pragma unroll 1
    for (int m = 0; m < 4; ++m)
      final_rows(PT, ZR, AA, Y, RW, Gs + (m * 16 + fr) * 520 + c0 + 8 * fq, t0 + m * 16 + fr, c0, fq, fr);
    __syncthreads();
  }
}

DI void p5_merge(const Params& P, char* smem) {
  const u16* WB = (const u16*)P.ws;
  EpiMergeCat E{(u16*)(P.ws + MERGED_OFF), (const u16*)(P.ws + GATES_OFF)};
  run_gemm_cat(smem, (const u16*)(P.ws + ATTN_OFF), WB + WT_UA, (const u16*)(P.ws + RW_OFF), WB + WT_UR, 1024, 512, E);
}
DI void p6_outproj(const Params& P, char* smem) {
  EpiResidP E{P.out, P.x};
  run_gemm(smem, (const u16*)(P.ws + MERGED_OFF), (const u16*)P.ws + WT_OUT, 1024, 1024, E);
}
DI void p8_ff1(const Params& P, char* smem) {
  EpiRelu2P E{(u16*)(P.ws + HID_OFF)};
  run_gemm(smem, (const u16*)(P.ws + HF_OFF), (const u16*)P.ws + WT_FF1, 4096, 1024, E);
}
DI void p9_ff2(const Params& P, char* smem) {
  EpiResidP E{P.out, P.out};
  run_gemm(smem, (const u16*)(P.ws + HID_OFF), (const u16*)P.ws + WT_FF2, 1024, 4096, E);
}
DI void p10_cvt_p(const Params& P) {
  u16* PB = (u16*)(P.ws + PB_OFF);
  const float4* p4 = (const float4*)P.p;
  for (int e = blockIdx.x * NTHR + threadIdx.x; e < T * 256 / 4; e += gridDim.x * NTHR) {
    float4 v = p4[e]; uint2 o; o.x = pack2(v.x, v.y); o.y = pack2(v.z, v.w);
    *(uint2*)(PB + (size_t)e * 4) = o;
  }
}
DI void p11_ple(const Params& P, char* smem) {
  const u16* WB = (const u16*)P.ws;
  EpiStoreBfP E1{(u16*)(P.ws + PE_OFF)};
  run_gemm(smem, (const u16*)(P.ws + PB_OFF), WB + WT_PL, 1024, 256, E1);
  EpiPle2P E2{P.out, (const u16*)(P.ws + PE_OFF)};
  run_gemm(smem, (const u16*)(P.ws + HP_OFF), WB + WT_PG, 1024, 1024, E2);
}

constexpr size_t BAR_OFF = 33292288;
__global__ void __launch_bounds__(NTHR) mega(Params P, int never) {
  extern __shared__ __attribute__((aligned(16))) char smem[];
  volatile LAS unsigned* st = (volatile LAS unsigned*)(smem + 131072);
  if (threadIdx.x < 4) st[threadIdx.x] = 0u;
  __syncthreads();
  XcdBarrier xb = xcd_barrier_post((unsigned*)(P.ws + BAR_OFF), st);
  if (never) cg::this_grid().sync();
#define SYNC() xcd_barrier(xb)
  p0_prep(P, smem); rmsnorm_rows(P.x, P.norm_mix, (u16*)P.out); SYNC();
  p1_proj(P, smem); SYNC();
  p2_attn(P, smem); p2_prep(P, smem); SYNC();
  p3_scan(P, smem); SYNC();
  p4_final(P, smem); SYNC();
  p5_merge(P, smem); SYNC();
  p6_outproj(P, smem); SYNC();
  rmsnorm_rows(P.out, P.norm_ffn, (u16*)(P.ws + HF_OFF)); SYNC();
  p8_ff1(P, smem); SYNC();
  p9_ff2(P, smem); SYNC();
  rmsnorm_rows(P.out, P.norm_ple, (u16*)(P.ws + HP_OFF)); p10_cvt_p(P); SYNC();
  p11_ple(P, smem);
#undef SYNC
}

extern "C" void kernel_launch(void* const* d_in, const int* in_sizes, int n_in, void* d_out, int out_size, void* d_ws,
                              size_t ws_size, hipStream_t stream) {
  static int grid = 0;
  if (grid == 0) {
    int dev = 0, cus = 0, per_cu = 0;
    (void)hipGetDevice(&dev);
    (void)hipDeviceGetAttribute(&cus, hipDeviceAttributeMultiprocessorCount, dev);
    (void)hipFuncSetAttribute((const void*)mega, hipFuncAttributeMaxDynamicSharedMemorySize, LDS_BYTES);
    (void)hipOccupancyMaxActiveBlocksPerMultiprocessor(&per_cu, (const void*)mega, NTHR, LDS_BYTES);
    if (per_cu < 1) per_cu = 1;
    grid = cus * per_cu;
    if (ws_size < 268435456ull) fprintf(stderr, "kernel_launch: workspace too small: %zu\n", ws_size);
    fprintf(stderr, "kernel_launch: grid %d (cus %d x %d)\n", grid, cus, per_cu);
  }
  Params P{};
  const float** pp = (const float**)&P;
  for (int i = 0; i < 27; ++i) pp[i] = (const float*)d_in[i];
  P.out = (float*)d_out; P.ws = (char*)d_ws;
  (void)hipMemsetAsync((char*)d_ws + BAR_OFF, 0, XCD_BAR_WORDS * 4, stream);
  int never = 0;
  void* args[] = {&P, &never};
  hipError_t e = hipLaunchCooperativeKernel((const void*)mega, dim3(grid), dim3(NTHR), args, LDS_BYTES, stream);
  if (e != hipSuccess) fprintf(stderr, "cooperative launch failed: %s\n", hipGetErrorString(e));
}
```

```cpp
#include <hip/hip_runtime.h>
#include <hip/hip_cooperative_groups.h>
#include <cstdio>
namespace cg = cooperative_groups;

#define DI __device__ __forceinline__
typedef unsigned short u16;
using bf16x8 = __attribute__((ext_vector_type(8))) short;
using f32x4 = __attribute__((ext_vector_type(4))) float;

constexpr int T = 16384, S = 4096;
constexpr int NTHR = 512;
constexpr int LDS_BYTES = 131072 + 64;
#ifndef ONE_LAUNCH
#define ONE_LAUNCH 1
#endif

constexpr size_t WT_IN = 0, WT_UA = 4718592, WT_UR = 5242880, WT_OUT = 5767168, WT_FF1 = 6815744,
                 WT_FF2 = 11010048, WT_PG = 15204352, WT_PL = 16252928;
constexpr size_t ROT_OFF = 33030144;
constexpr size_t G2T_OFF = 33310208;
constexpr size_t W2T_OFF = 201326592;
constexpr size_t QKV_OFF = 33554432;
constexpr size_t K_OFF = QKV_OFF + 16777216, VT_OFF = K_OFF + 4194304;
constexpr size_t ZR_OFF = 58720256;
constexpr size_t GATES_OFF = 117440512;
constexpr size_t ATTN_OFF = 184549376;
constexpr size_t Y_OFF = 201326592;
constexpr size_t RW_OFF = QKV_OFF;
constexpr size_t MERGED_OFF = ZR_OFF;
constexpr size_t HF_OFF = Y_OFF;
constexpr size_t HID_OFF = QKV_OFF;
constexpr size_t HP_OFF = Y_OFF + 33554432;
constexpr size_t PB_OFF = ATTN_OFF;
constexpr size_t PE_OFF = QKV_OFF;

struct Params {
  const float *x, *p, *norm_mix, *w_in, *shift_mu, *q_norm, *k_norm, *sink, *w0, *w2, *a0, *a2, *g2, *k_k, *k_a,
      *r_k, *lnx_w, *lnx_b, *w_up_attn, *w_up_rwkv, *w_out, *norm_ffn, *w_ff1, *w_ff2, *norm_ple, *w_ple_gate, *w_ple;
  float* out;
  char* ws;
};

typedef float f32x2v __attribute__((ext_vector_type(2)));
typedef __bf16 bf16x2v __attribute__((ext_vector_type(2)));
DI unsigned pack2(float a, float b) { f32x2v f = {a, b}; return __builtin_bit_cast(unsigned, __builtin_convertvector(f, bf16x2v)); }
DI u16 f2bf(float x) { return (u16)(pack2(x, 0.f) & 0xffffu); }
DI float bf2f(u16 h) { return __uint_as_float(((unsigned)h) << 16); }
DI float bflo(unsigned w) { return __uint_as_float(w << 16); }
DI float bfhi(unsigned w) { return __uint_as_float(w & 0xffff0000u); }
DI uint2 pack4(f32x4 v) { return make_uint2(pack2(v[0], v[1]), pack2(v[2], v[3])); }
DI void unpack8(const uint4 w, float (&f)[8]) { f[0] = bflo(w.x); f[1] = bfhi(w.x); f[2] = bflo(w.y); f[3] = bfhi(w.y); f[4] = bflo(w.z); f[5] = bfhi(w.z); f[6] = bflo(w.w); f[7] = bfhi(w.w); }
DI uint4 pack8(f32x4 a, f32x4 b) { return make_uint4(pack2(a[0], a[1]), pack2(a[2], a[3]), pack2(b[0], b[1]), pack2(b[2], b[3])); }
DI float vmax_raw(float a, float b) { float r; asm("v_max_f32 %0, %1, %2" : "=v"(r) : "v"(a), "v"(b)); return r; }
DI float vmax3_raw(float a, float b, float c) { float r; asm("v_max3_f32 %0, %1, %2, %3" : "=v"(r) : "v"(a), "v"(b), "v"(c)); return r; }
DI float relu_raw(float a) { float r; asm("v_max_f32 %0, 0, %1" : "=v"(r) : "v"(a)); return r; }
DI int tid_fresh() { int t = threadIdx.x; asm volatile("" : "+v"(t)); return t; }
DI float sigmoidf(float x) { return __builtin_amdgcn_rcpf(1.f + __expf(-x)); }
DI float wave_sum(float v) { for (int m = 32; m >= 1; m >>= 1) v += __shfl_xor(v, m); return v; }
DI float wave_max(float v) { for (int m = 32; m >= 1; m >>= 1) v = fmaxf(v, __shfl_xor(v, m)); return v; }
template <int CTRL> DI float dppf(float x) {
  return __int_as_float(__builtin_amdgcn_update_dpp(0, __float_as_int(x), CTRL, 0xF, 0xF, true));
}
DI float row16_sum(float v) {
  v += dppf<0xB1>(v);
  v += dppf<0x4E>(v);
  v += dppf<0x141>(v);
  v += dppf<0x140>(v);
  return v;
}
DI float zshift(const u16* ZR, int t, int s, int col, float mu) {
  float z = bf2f(ZR[(size_t)t * 1792 + col]);
  float pv = s > 0 ? bf2f(ZR[(size_t)(t - 1) * 1792 + col]) : 0.f;
  float nx = s < S - 1 ? bf2f(ZR[(size_t)(t + 1) * 1792 + col]) : 0.f;
  return z + mu * (0.5f * (pv + nx) - z);
}

DI void p0_prep(const Params& P, char* smem) {
  const int tid = tid_fresh();
  float* tile = (float*)smem;
  u16* WB = (u16*)P.ws;
  for (int t = blockIdx.x; t < 4080; t += gridDim.x) {
    const float* src; u16* dst; int K, N, lt;
    if (t < 1152) { src = P.w_in; dst = WB + WT_IN; K = 1024; N = 4608; lt = t; }
    else if (t < 1280) { src = P.w_up_attn; dst = WB + WT_UA; K = 512; N = 1024; lt = t - 1152; }
    else if (t < 1408) { src = P.w_up_rwkv; dst = WB + WT_UR; K = 512; N = 1024; lt = t - 1280; }
    else if (t < 1664) { src = P.w_out; dst = WB + WT_OUT; K = 1024; N = 1024; lt = t - 1408; }
    else if (t < 2688) { src = P.w_ff1; dst = WB + WT_FF1; K = 1024; N = 4096; lt = t - 1664; }
    else if (t < 3712) { src = P.w_ff2; dst = WB + WT_FF2; K = 4096; N = 1024; lt = t - 2688; }
    else if (t < 3968) { src = P.w_ple_gate; dst = WB + WT_PG; K = 1024; N = 1024; lt = t - 3712; }
    else if (t < 4032) { src = P.w_ple; dst = WB + WT_PL; K = 256; N = 1024; lt = t - 3968; }
    else if (t < 4064) { const int mi = (t - 4032) >> 3; src = ((mi & 1) ? P.a2 : P.w2) + (size_t)(mi >> 1) * 64 * 512; dst = (u16*)(P.ws + W2T_OFF) + (size_t)mi * 512 * 64; K = 64; N = 512; lt = (t - 4032) & 7; }
    else { src = P.g2; dst = (u16*)(P.ws + G2T_OFF); K = 128; N = 512; lt = t - 4064; }
    const int ntn = N >> 6, k0 = (lt / ntn) * 64, n0 = (lt % ntn) * 64;
#pragma unroll
    for (int i = 0; i < 8; ++i) { int idx = i * NTHR + tid, r = idx >> 6, c = idx & 63; tile[r * 65 + c] = src[(size_t)(k0 + r) * N + n0 + c]; }
    __syncthreads();
#pragma unroll
    for (int i = 0; i < 8; ++i) { int idx = i * NTHR + tid, n = idx >> 6, k = idx & 63; dst[(size_t)(n0 + n) * K + k0 + k] = f2bf(tile[k * 65 + n]); }
    __syncthreads();
  }
  float* ROT = (float*)(P.ws + ROT_OFF);
  for (int e = blockIdx.x * NTHR + tid; e < 32768; e += gridDim.x * NTHR) {
    int pos = e >> 3, i = e & 7;
    float invf = i == 0 ? 1.0f : i == 1 ? 0.19392274f : i == 2 ? 0.03760603f : i == 3 ? 0.0072926646f
               : i == 4 ? 0.0014142136f : i == 5 ? 0.0002742482f : i == 6 ? 5.3182957e-05f : 1.0313385e-05f;
    float ang = (float)pos * invf;
    double a = (double)ang;
    double kq = rint(a * 0.15915494309189535);
    float rf = (float)(a - kq * 6.283185307179586476925);
    ROT[e] = cosf(rf); ROT[32768 + e] = sinf(rf);
  }
}

DI void rmsnorm_rows(const float* src, const float* gain, u16* dst) {
  const int tid = tid_fresh(), lane = tid & 63;
  const int nw = gridDim.x * 8;
  float4 g[4];
#pragma unroll
  for (int i = 0; i < 4; ++i) g[i] = ((const float4*)gain)[lane + i * 64];
  for (int row = blockIdx.x * 8 + (tid >> 6); row < T; row += 4 * nw) {
    float4 v[4][4]; float ss[4];
#pragma unroll
    for (int r = 0; r < 4; ++r) {
      const float4* s4 = (const float4*)(src + (size_t)(row + r * nw) * 1024);
      ss[r] = 0.f;
#pragma unroll
      for (int i = 0; i < 4; ++i) { v[r][i] = (row + r * nw < T) ? s4[lane + i * 64] : make_float4(0.f, 0.f, 0.f, 0.f); }
    }
#pragma unroll
    for (int r = 0; r < 4; ++r) {
#pragma unroll
      for (int i = 0; i < 4; ++i) ss[r] += v[r][i].x * v[r][i].x + v[r][i].y * v[r][i].y + v[r][i].z * v[r][i].z + v[r][i].w * v[r][i].w;
      ss[r] = wave_sum(ss[r]);
      const float sc = rsqrtf(ss[r] * (1.f / 1024.f) + 1e-6f);
      if (row + r * nw < T)
#pragma unroll
      for (int i = 0; i < 4; ++i) {
        uint2 o; o.x = pack2(v[r][i].x * sc * g[i].x, v[r][i].y * sc * g[i].y); o.y = pack2(v[r][i].z * sc * g[i].z, v[r][i].w * sc * g[i].w);
        *(uint2*)(dst + (size_t)(row + r * nw) * 1024 + (lane + i * 64) * 4) = o;
      }
    }
  }
}

namespace pg8 {
#define PG8_LAS __attribute__((address_space(3)))
typedef unsigned short bf16_t;
typedef short bf16x8 __attribute__((ext_vector_type(8)));
typedef float f32x4 __attribute__((ext_vector_type(4)));
typedef unsigned u32x4 __attribute__((ext_vector_type(4)));
constexpr int BM = 256, BK = 64, HALF = 128, HTB = HALF * BK * 2  , STAGE_BYTES = 8 * HTB, NXCD = 8, WGM = 4;

__host__ __device__ __forceinline__ int lds_byte(int r, int c) { const int st = (r >> 4) * 2 + (c >> 5), rr = r & 15, cc = c & 31, ob = rr * 64 + cc * 2; return st * 1024 + (ob ^ (((ob >> 9) & 1) << 5)); }
__host__ __device__ __forceinline__ void stage_rc(int b, int& R, int& C) { const int st = b / 1024, sb = b % 1024, swz = sb ^ (((sb >> 9) & 1) << 5); R = (st >> 1) * 16 + swz / 64; C = (st & 1) * 32 + (swz % 64) / 2; }
__host__ __device__ __forceinline__ int perm32(int rho) { const int n = rho >> 4, i = rho & 15; return 8 * (i >> 2) + 4 * n + (i & 3); }

struct Unit { int pm, pn; };
struct Gemm { const bf16_t* A; const bf16_t* Bt; int M, N, K; };

struct StaticOrder {
    int nM, nN, nwg, G, c;
    __host__ __device__ void init(int M, int N, int G_, int c_) { nM = M / BM; nN = N / BM; nwg = nM * nN; G = G_; c = c_; }
    __host__ __device__ bool next(int i, Unit& u) const {
        const long L = (long)i * G + c; if (L >= nwg) return false;
        int wgid = (int)L; { const int q = nwg / NXCD, r = nwg % NXCD, xcd = wgid % NXCD, off = wgid / NXCD; wgid = (xcd < r ? xcd * (q + 1) : r * (q + 1) + (xcd - r) * q) + off; }
        const int nig = WGM * nN, gid = wgid / nig, fm = gid * WGM, gsz = (nM - fm) < WGM ? (nM - fm) : WGM;
        u.pm = fm + ((wgid % nig) % gsz); u.pn = (wgid % nig) / gsz; return true;
    }
    __device__ __forceinline__ void a_ready(const Unit&) const {}
    __device__ __forceinline__ void done(const Unit&) const {}
};
template <class Epi, class Sched, bool STAMP = false>
__device__ __forceinline__ void gemm_phase(PG8_LAS unsigned char* lds, const Gemm g, const Sched& S, const Epi& E, unsigned long long* stamps) {
    const int tid = tid_fresh(), wid = __builtin_amdgcn_readfirstlane(tid >> 6), lane = tid & 63, wr = wid >> 2, wc = wid & 3, fr = lane & 15, fq = lane >> 4;
    const int K = g.K, nt = K / BK;
    int ts_lo = 0, ts_hi = 0, nts = 0; const unsigned long long rt_entry = STAMP ? (unsigned long long)wall_clock64() : 0ull;
#define PG8_STAMP() do { if (STAMP && wid == 0 && nts < 64) { const unsigned long long _c = (unsigned long long)clock64(); \
        ts_lo = (lane == nts) ? (int)(unsigned)_c : ts_lo; ts_hi = (lane == nts) ? (int)(unsigned)(_c >> 32) : ts_hi; ++nts; } } while (0)
    PG8_STAMP();
    unsigned voffA[2], voffB[2];
#pragma unroll
    for (int i = 0; i < 2; ++i) { int R, C; stage_rc(tid * 16 + i * 8192, R, C); const int Rb = Epi::PERM ? ((R & ~31) + perm32(R & 31)) : R;
        voffA[i] = (unsigned)(R * K + C) * 2u; voffB[i] = (unsigned)(Rb * K + C) * 2u; }
    const size_t kstep = (size_t)(BK * 2);
    const size_t hstep = (size_t)HALF * K * 2;
    const size_t tstep = 2 * hstep;
    const unsigned ldsw = (unsigned)wid * 1024u;
    const int aoff = lds_byte(wr * 64 + fr, fq * 8), boff = lds_byte(wc * 32 + fr, fq * 8);
#define PG8_SA(b, h) (((b) * 2 + (h)) * HTB)
#define PG8_SB(b, h) ((4 + (b) * 2 + (h)) * HTB)
#define PG8_STAGE(bufoff, gbase, voff) do { _Pragma("unroll") for (int _i = 0; _i < 2; ++_i) \
        __builtin_amdgcn_global_load_lds((const unsigned*)((const char*)(gbase) + (voff)[_i]), (PG8_LAS unsigned*)(lds + (bufoff) + ldsw + _i * 8192), 16, 0, 0); } while (0)
#define PG8_LDA(dst, b, h) do { _Pragma("unroll") for (int m = 0; m < 4; ++m) _Pragma("unroll") for (int k = 0; k < 2; ++k) dst[m][k] = *(const PG8_LAS bf16x8*)(lds + PG8_SA(b, h) + aoff + m * 2048 + k * 1024); } while (0)
#define PG8_LDB(dst, b, h) do { _Pragma("unroll") for (int n = 0; n < 2; ++n) _Pragma("unroll") for (int k = 0; k < 2; ++k) dst[n][k] = *(const PG8_LAS bf16x8*)(lds + PG8_SB(b, h) + boff + n * 2048 + k * 1024); } while (0)
#define PG8_MMA(ai, bj, At, Bt) do { __builtin_amdgcn_s_setprio(1); _Pragma("unroll") for (int m = 0; m < 4; ++m) _Pragma("unroll") for (int n = 0; n < 2; ++n) _Pragma("unroll") for (int k = 0; k < 2; ++k) \
        acc[ai][bj][m][n] = __builtin_amdgcn_mfma_f32_16x16x32_bf16(Bt[n][k], At[m][k], acc[ai][bj][m][n], 0, 0, 0); __builtin_amdgcn_s_setprio(0); } while (0)
#define PG8_WAIT_V(n) asm volatile("s_waitcnt vmcnt(" #n ")" ::: "memory")
#define PG8_WAIT_L(n) asm volatile("s_waitcnt lgkmcnt(" #n ")" ::: "memory")
#define PG8_BAR __builtin_amdgcn_s_barrier()
#define PG8_SCHED __builtin_amdgcn_sched_barrier(0)
    Unit cur, nxt; int ui = 0;
    if (!S.next(0, cur)) return;
    f32x4 acc[2][2][4][2];
#pragma unroll
    for (int a = 0; a < 2; ++a)
#pragma unroll
        for (int b = 0; b < 2; ++b)
#pragma unroll
            for (int m = 0; m < 4; ++m)
#pragma unroll
                for (int n = 0; n < 2; ++n) acc[a][b][m][n] = (f32x4){0.f, 0.f, 0.f, 0.f};
    bf16x8 At[4][2], B0[2][2], B1[2][2];
    const char* cA = (const char*)g.A + (size_t)cur.pm * tstep; const char* cB = (const char*)g.Bt + (size_t)cur.pn * tstep;
    S.a_ready(cur);
    PG8_STAGE(PG8_SB(0, 0), cB, voffB); PG8_STAGE(PG8_SA(0, 0), cA, voffA); PG8_STAGE(PG8_SB(0, 1), cB + hstep, voffB); PG8_STAGE(PG8_SA(0, 1), cA + hstep, voffA);
    if (wr == 1) PG8_BAR;
    PG8_WAIT_V(4); PG8_BAR;
    PG8_STAGE(PG8_SB(1, 0), cB + kstep, voffB); PG8_STAGE(PG8_SA(1, 0), cA + kstep, voffA); PG8_STAGE(PG8_SB(1, 1), cB + hstep + kstep, voffB);
    PG8_WAIT_V(6); PG8_BAR;
    PG8_STAMP();
    for (;;) {
        const bool has_next = S.next(ui + 1, nxt);
        const char* nA = has_next ? (const char*)g.A + (size_t)nxt.pm * tstep : cA; const char* nB = has_next ? (const char*)g.Bt + (size_t)nxt.pn * tstep : cB;
        for (int t = 0; t < nt; t += 2) {
            const bool last = (t == nt - 2);
            const char* a1 = cA + (size_t)(t + 1) * kstep;
            const char* a2 = last ? nA : cA + (size_t)(t + 2) * kstep; const char* b2 = last ? nB : cB + (size_t)(t + 2) * kstep;
            const char* a3 = a2 + kstep; const char* b3 = b2 + kstep;
            if (last && has_next) S.a_ready(nxt);
            PG8_LDB(B0, 0, 0); PG8_SCHED; PG8_LDA(At, 0, 0); PG8_STAGE(PG8_SA(1, 1), a1 + hstep, voffA);
            PG8_WAIT_L(8); PG8_BAR; PG8_WAIT_L(0); PG8_MMA(0, 0, At, B0); PG8_BAR; PG8_SCHED;
            PG8_LDB(B1, 0, 1); PG8_STAGE(PG8_SB(0, 0), b2, voffB);
            PG8_BAR; PG8_WAIT_L(0); PG8_MMA(0, 1, At, B1); PG8_BAR;
            PG8_LDA(At, 0, 1); PG8_STAGE(PG8_SA(0, 0), a2, voffA);
            PG8_BAR; PG8_WAIT_L(0); PG8_MMA(1, 0, At, B0); PG8_BAR; PG8_SCHED;
            PG8_STAGE(PG8_SB(0, 1), b2 + hstep, voffB);
            PG8_WAIT_V(6); PG8_BAR; PG8_MMA(1, 1, At, B1); PG8_BAR;
            PG8_LDB(B0, 1, 0); PG8_SCHED; PG8_LDA(At, 1, 0); PG8_STAGE(PG8_SA(0, 1), a2 + hstep, voffA);
            PG8_WAIT_L(8); PG8_BAR; PG8_WAIT_L(0); PG8_MMA(0, 0, At, B0); PG8_BAR; PG8_SCHED;
            PG8_LDB(B1, 1, 1); PG8_STAGE(PG8_SB(1, 0), b3, voffB);
            PG8_BAR; PG8_WAIT_L(0); PG8_MMA(0, 1, At, B1); PG8_BAR;
            PG8_LDA(At, 1, 1); PG8_STAGE(PG8_SA(1, 0), a3, voffA);
            PG8_BAR; PG8_WAIT_L(0); PG8_MMA(1, 0, At, B0); PG8_BAR; PG8_SCHED;
            PG8_STAGE(PG8_SB(1, 1), b3 + hstep, voffB);
            PG8_WAIT_V(6); PG8_BAR; PG8_MMA(1, 1, At, B1); PG8_BAR;
        }
        PG8_STAMP();
        if constexpr (!Epi::AFTER_DRAIN) { E(acc, cur, wr, wc, fr, fq); S.done(cur); }
        PG8_STAMP();
        if (!has_next) break;
#pragma unroll
        for (int a = 0; a < 2; ++a)
#pragma unroll
            for (int b = 0; b < 2; ++b)
#pragma unroll
                for (int m = 0; m < 4; ++m)
#pragma unroll
                    for (int n = 0; n < 2; ++n) acc[a][b][m][n] = (f32x4){0.f, 0.f, 0.f, 0.f};
        cur = nxt; cA = nA; cB = nB; ++ui;
    }
    PG8_WAIT_V(0);
    if (wr == 0) PG8_BAR;
    PG8_BAR;
    if constexpr (Epi::AFTER_DRAIN) { E.fused(acc, cur, wr, wc, fr, fq, lds, wid, lane); S.done(cur); }
    PG8_STAMP();
    if (STAMP && wid == 0) { stamps[lane] = lane < nts ? (((unsigned long long)(unsigned)ts_hi << 32) | (unsigned)ts_lo) : 0ull;
        if (lane == 62) stamps[62] = rt_entry; if (lane == 63) stamps[63] = (unsigned long long)wall_clock64(); }
#undef PG8_STAMP
#undef PG8_SA
#undef PG8_SB
#undef PG8_STAGE
#undef PG8_LDA
#undef PG8_LDB
#undef PG8_MMA
#undef PG8_WAIT_V
#undef PG8_WAIT_L
#undef PG8_BAR
#undef PG8_SCHED
}
template <class Epi, class Sched, bool STAMP = false>
__device__ __forceinline__ void gemm_phase_cat(PG8_LAS unsigned char* lds, const Gemm g, const bf16_t* A2, const bf16_t* Bt2, const Sched& S, const Epi& E, unsigned long long* stamps) {
    const int tid = tid_fresh(), wid = __builtin_amdgcn_readfirstlane(tid >> 6), lane = tid & 63, wr = wid >> 2, wc = wid & 3, fr = lane & 15, fq = lane >> 4;
    const int K = g.K, nth = K / BK, nt = 2 * nth;
    int ts_lo = 0, ts_hi = 0, nts = 0; const unsigned long long rt_entry = STAMP ? (unsigned long long)wall_clock64() : 0ull;
#define PG8_STAMP() do { if (STAMP && wid == 0 && nts < 64) { const unsigned long long _c = (unsigned long long)clock64(); \
        ts_lo = (lane == nts) ? (int)(unsigned)_c : ts_lo; ts_hi = (lane == nts) ? (int)(unsigned)(_c >> 32) : ts_hi; ++nts; } } while (0)
    PG8_STAMP();
    unsigned voffA[2], voffB[2];
#pragma unroll
    for (int i = 0; i < 2; ++i) { int R, C; stage_rc(tid * 16 + i * 8192, R, C); const int Rb = Epi::PERM ? ((R & ~31) + perm32(R & 31)) : R;
        voffA[i] = (unsigned)(R * K + C) * 2u; voffB[i] = (unsigned)(Rb * K + C) * 2u; }
    const size_t kstep = (size_t)(BK * 2);
    const size_t hstep = (size_t)HALF * K * 2;
    const size_t tstep = 2 * hstep;
    const unsigned ldsw = (unsigned)wid * 1024u;
    const int aoff = lds_byte(wr * 64 + fr, fq * 8), boff = lds_byte(wc * 32 + fr, fq * 8);
#define PG8_SA(b, h) (((b) * 2 + (h)) * HTB)
#define PG8_SB(b, h) ((4 + (b) * 2 + (h)) * HTB)
#define PG8_STAGE(bufoff, gbase, voff) do { _Pragma("unroll") for (int _i = 0; _i < 2; ++_i) \
        __builtin_amdgcn_global_load_lds((const unsigned*)((const char*)(gbase) + (voff)[_i]), (PG8_LAS unsigned*)(lds + (bufoff) + ldsw + _i * 8192), 16, 0, 0); } while (0)
#define PG8_LDA(dst, b, h) do { _Pragma("unroll") for (int m = 0; m < 4; ++m) _Pragma("unroll") for (int k = 0; k < 2; ++k) dst[m][k] = *(const PG8_LAS bf16x8*)(lds + PG8_SA(b, h) + aoff + m * 2048 + k * 1024); } while (0)
#define PG8_LDB(dst, b, h) do { _Pragma("unroll") for (int n = 0; n < 2; ++n) _Pragma("unroll") for (int k = 0; k < 2; ++k) dst[n][k] = *(const PG8_LAS bf16x8*)(lds + PG8_SB(b, h) + boff + n * 2048 + k * 1024); } while (0)
#define PG8_MMA(ai, bj, At, Bt) do { __builtin_amdgcn_s_setprio(1); _Pragma("unroll") for (int m = 0; m < 4; ++m) _Pragma("unroll") for (int n = 0; n < 2; ++n) _Pragma("unroll") for (int k = 0; k < 2; ++k) \
        acc[ai][bj][m][n] = __builtin_amdgcn_mfma_f32_16x16x32_bf16(Bt[n][k], At[m][k], acc[ai][bj][m][n], 0, 0, 0); __builtin_amdgcn_s_setprio(0); } while (0)
#define PG8_WAIT_V(n) asm volatile("s_waitcnt vmcnt(" #n ")" ::: "memory")
#define PG8_WAIT_L(n) asm volatile("s_waitcnt lgkmcnt(" #n ")" ::: "memory")
#define PG8_BAR __builtin_amdgcn_s_barrier()
#define PG8_SCHED __builtin_amdgcn_sched_barrier(0)
    Unit cur, nxt; int ui = 0;
    if (!S.next(0, cur)) return;
    f32x4 acc[2][2][4][2];
#pragma unroll
    for (int a = 0; a < 2; ++a)
#pragma unroll
        for (int b = 0; b < 2; ++b)
#pragma unroll
            for (int m = 0; m < 4; ++m)
#pragma unroll
                for (int n = 0; n < 2; ++n) acc[a][b][m][n] = (f32x4){0.f, 0.f, 0.f, 0.f};
    bf16x8 At[4][2], B0[2][2], B1[2][2];
    const char* cA = (const char*)g.A + (size_t)cur.pm * tstep; const char* cB = (const char*)g.Bt + (size_t)cur.pn * tstep;
    const char* cA2 = (const char*)A2 + (size_t)cur.pm * tstep; const char* cB2 = (const char*)Bt2 + (size_t)cur.pn * tstep;
    S.a_ready(cur);
    PG8_STAGE(PG8_SB(0, 0), cB, voffB); PG8_STAGE(PG8_SA(0, 0), cA, voffA); PG8_STAGE(PG8_SB(0, 1), cB + hstep, voffB); PG8_STAGE(PG8_SA(0, 1), cA + hstep, voffA);
    if (wr == 1) PG8_BAR;
    PG8_WAIT_V(4); PG8_BAR;
    PG8_STAGE(PG8_SB(1, 0), cB + kstep, voffB); PG8_STAGE(PG8_SA(1, 0), cA + kstep, voffA); PG8_STAGE(PG8_SB(1, 1), cB + hstep + kstep, voffB);
    PG8_WAIT_V(6); PG8_BAR;
    PG8_STAMP();
    for (;;) {
        const bool has_next = S.next(ui + 1, nxt);
        const char* nA = has_next ? (const char*)g.A + (size_t)nxt.pm * tstep : cA; const char* nB = has_next ? (const char*)g.Bt + (size_t)nxt.pn * tstep : cB;
        for (int t = 0; t < nt; t += 2) {
            const bool last = (t == nt - 2);
            const char* a1 = (t < nth ? cA : cA2 - (size_t)nth * kstep) + (size_t)(t + 1) * kstep;
            const char* a2 = last ? nA : (t + 2 < nth ? cA : cA2 - (size_t)nth * kstep) + (size_t)(t + 2) * kstep;
            const char* b2 = last ? nB : (t + 2 < nth ? cB : cB2 - (size_t)nth * kstep) + (size_t)(t + 2) * kstep;
            if (t == nth) E.mid(acc, cur, wr, wc, fr, fq);
            const char* a3 = a2 + kstep; const char* b3 = b2 + kstep;
            if (last && has_next) S.a_ready(nxt);
            PG8_LDB(B0, 0, 0); PG8_SCHED; PG8_LDA(At, 0, 0); PG8_STAGE(PG8_SA(1, 1), a1 + hstep, voffA);
            PG8_WAIT_L(8); PG8_BAR; PG8_WAIT_L(0); PG8_MMA(0, 0, At, B0); PG8_BAR; PG8_SCHED;
            PG8_LDB(B1, 0, 1); PG8_STAGE(PG8_SB(0, 0), b2, voffB);
            PG8_BAR; PG8_WAIT_L(0); PG8_MMA(0, 1, At, B1); PG8_BAR;
            PG8_LDA(At, 0, 1); PG8_STAGE(PG8_SA(0, 0), a2, voffA);
            PG8_BAR; PG8_WAIT_L(0); PG8_MMA(1, 0, At, B0); PG8_BAR; PG8_SCHED;
            PG8_STAGE(PG8_SB(0, 1), b2 + hstep, voffB);
            PG8_WAIT_V(6); PG8_BAR; PG8_MMA(1, 1, At, B1); PG8_BAR;
            PG8_LDB(B0, 1, 0); PG8_SCHED; PG8_LDA(At, 1, 0); PG8_STAGE(PG8_SA(0, 1), a2 + hstep, voffA);
            PG8_WAIT_L(8); PG8_BAR; PG8_WAIT_L(0); PG8_MMA(0, 0, At, B0); PG8_BAR; PG8_SCHED;
            PG8_LDB(B1, 1, 1); PG8_STAGE(PG8_SB(1, 0), b3, voffB);
            PG8_BAR; PG8_WAIT_L(0); PG8_MMA(0, 1, At, B1); PG8_BAR;
            PG8_LDA(At, 1, 1); PG8_STAGE(PG8_SA(1, 0), a3, voffA);
            PG8_BAR; PG8_WAIT_L(0); PG8_MMA(1, 0, At, B0); PG8_BAR; PG8_SCHED;
            PG8_STAGE(PG8_SB(1, 1), b3 + hstep, voffB);
            PG8_WAIT_V(6); PG8_BAR; PG8_MMA(1, 1, At, B1); PG8_BAR;
        }
        PG8_STAMP();
        if constexpr (!Epi::AFTER_DRAIN) { E(acc, cur, wr, wc, fr, fq); S.done(cur); }
        PG8_STAMP();
        if (!has_next) break;
#pragma unroll
        for (int a = 0; a < 2; ++a)
#pragma unroll
            for (int b = 0; b < 2; ++b)
#pragma unroll
                for (int m = 0; m < 4; ++m)
#pragma unroll
                    for (int n = 0; n < 2; ++n) acc[a][b][m][n] = (f32x4){0.f, 0.f, 0.f, 0.f};
        cur = nxt; cA = nA; cB = nB; cA2 = (const char*)A2 + (size_t)cur.pm * tstep; cB2 = (const char*)Bt2 + (size_t)cur.pn * tstep; ++ui;
    }
    PG8_WAIT_V(0);
    if (wr == 0) PG8_BAR;
    PG8_BAR;
    if constexpr (Epi::AFTER_DRAIN) { E.fused(acc, cur, wr, wc, fr, fq, lds, wid, lane); S.done(cur); }
    PG8_STAMP();
    if (STAMP && wid == 0) { stamps[lane] = lane < nts ? (((unsigned long long)(unsigned)ts_hi << 32) | (unsigned)ts_lo) : 0ull;
        if (lane == 62) stamps[62] = rt_entry; if (lane == 63) stamps[63] = (unsigned long long)wall_clock64(); }
#undef PG8_STAMP
#undef PG8_SA
#undef PG8_SB
#undef PG8_STAGE
#undef PG8_LDA
#undef PG8_LDB
#undef PG8_MMA
#undef PG8_WAIT_V
#undef PG8_WAIT_L
#undef PG8_BAR
#undef PG8_SCHED
}
}
using pg8::Unit;
#define XB_TMO      128
#define XB_XCNT(j)  (256  + 64 * (j))
#define XB_XSUB(j)  (1280 + 64 * (j))
#define XB_XGEN(j)  (2304 + 64 * (j))
#define XB_TOP      3328
#define XB_TOPGEN   3392
#define XCD_BAR_WORDS 3456
#define XB_SPIN_CAP (1u << 18)
#define LAS __attribute__((address_space(3)))

__device__ __forceinline__ unsigned xb_ld(unsigned* p)              { return __hip_atomic_load(p, __ATOMIC_RELAXED, __HIP_MEMORY_SCOPE_AGENT); }
__device__ __forceinline__ unsigned xb_add(unsigned* p, unsigned v) { return __hip_atomic_fetch_add(p, v, __ATOMIC_RELAXED, __HIP_MEMORY_SCOPE_AGENT); }
__device__ __forceinline__ unsigned xb_xcc_id() { return (unsigned)__builtin_amdgcn_s_getreg((3 << 11) | 20) & 0xFu; }
#define XB_SPIN(cond, bar) do { unsigned _sp = 0; while (cond) { __builtin_amdgcn_s_sleep(1); \
    if ((++_sp & 255u) == 0u) { if (xb_ld(&(bar)[XB_TMO])) break; if (_sp > XB_SPIN_CAP) { atomicAdd(&(bar)[XB_TMO], 1u); break; } } } } while (0)

struct XcdBarrier {
    unsigned* bar; unsigned x;
    volatile LAS unsigned* st;
};

__device__ __forceinline__ XcdBarrier xcd_barrier_post(unsigned* bar, volatile LAS unsigned* st) {
    XcdBarrier b; b.bar = bar; b.x = xb_xcc_id(); b.st = st;
    if (threadIdx.x == 0) (void)xb_add(&bar[XB_XCNT(b.x)], 1u);
    return b;
}
__device__ __forceinline__ void xcd_barrier_complete(unsigned* bar, unsigned x, unsigned& nloc, unsigned& nx) {
    const unsigned G = gridDim.x * gridDim.y * gridDim.z;
    unsigned sum, cnt, mine, sp = 0u;
    for (;;) {
        sum = 0u; cnt = 0u; mine = 0u;
#pragma unroll
        for (unsigned j = 0; j < 16; ++j) { const unsigned c = xb_ld(&bar[XB_XCNT(j)]); sum += c; cnt += (c > 0u) ? 1u : 0u; mine = (j == x) ? c : mine; }
        if (sum == G) break;
        __builtin_amdgcn_s_sleep(1);
        if ((++sp & 255u) == 0u) { if (xb_ld(&bar[XB_TMO])) break; if (sp > XB_SPIN_CAP) { atomicAdd(&bar[XB_TMO], 1u); break; } }
    }
    nloc = mine > 0u ? mine : 1u; nx = cnt > 0u ? cnt : 1u;
}

__device__ __forceinline__ void xcd_barrier(const XcdBarrier& b) {
    asm volatile("s_waitcnt vmcnt(0)" ::: "memory");
    __syncthreads();
    if (threadIdx.x == 0) {
        unsigned* bar = b.bar;
        __builtin_amdgcn_s_waitcnt(0);
        unsigned nloc = b.st[0], nx = b.st[1];
        if (nloc == 0u) { xcd_barrier_complete(bar, b.x, nloc, nx); b.st[0] = nloc; b.st[1] = nx; }
        const unsigned old = xb_add(&bar[XB_XSUB(b.x)], 1u);
        const unsigned gen = old / nloc;
        if (old + 1u == (gen + 1u) * nloc) {
            __builtin_amdgcn_fence(__ATOMIC_RELEASE, "agent");
            asm volatile("s_waitcnt vmcnt(0)" ::: "memory");
            const unsigned og = xb_add(&bar[XB_TOP], 1u);
            const unsigned tg = og / nx;
            if (og + 1u == (tg + 1u) * nx) xb_add(&bar[XB_TOPGEN], 1u);
            else XB_SPIN(xb_ld(&bar[XB_TOPGEN]) == tg, bar);
            __builtin_amdgcn_fence(__ATOMIC_ACQUIRE, "agent");
            xb_add(&bar[XB_XGEN(b.x)], 1u);
            asm volatile("s_waitcnt vmcnt(0)" ::: "memory");
        } else {
            XB_SPIN(xb_ld(&bar[XB_XGEN(b.x)]) == gen, bar);
            __builtin_amdgcn_fence(__ATOMIC_ACQUIRE, "agent");
            asm volatile("s_waitcnt vmcnt(0)" ::: "memory");
        }
    }
    __syncthreads();
}

#define EPI_FOR(...) do { const int row0_ = u.pm * 256 + wr * 64 + fr, col0_ = u.pn * 256 + wc * 32 + 4 * fq; \
    _Pragma("unroll") for (int ai = 0; ai < 2; ++ai) _Pragma("unroll") for (int m = 0; m < 4; ++m) { const size_t row = (size_t)(row0_ + ai * 128 + m * 16); \
      _Pragma("unroll") for (int bj = 0; bj < 2; ++bj) _Pragma("unroll") for (int n = 0; n < 2; ++n) { const int col = col0_ + bj * 128 + n * 16; const f32x4 v = acc[ai][bj][m][n]; __VA_ARGS__ } \
      if (m & 1) asm volatile("" ::: "memory"); } } while (0)
#define EPI_HEAD static constexpr bool PERM = false, AFTER_DRAIN = false; \
  DI void operator()(const f32x4 (&acc)[2][2][4][2], const Unit& u, int wr, int wc, int fr, int fq) const

#define EPI_FOR8(...) do { const int row0_ = u.pm * 256 + wr * 64 + fr, col0_ = u.pn * 256 + wc * 32 + 8 * fq; \
    _Pragma("unroll") for (int ai = 0; ai < 2; ++ai) _Pragma("unroll") for (int m = 0; m < 4; ++m) { const size_t row = (size_t)(row0_ + ai * 128 + m * 16); \
      _Pragma("unroll") for (int bj = 0; bj < 2; ++bj) { const int col = col0_ + bj * 128; const f32x4 v0 = acc[ai][bj][m][0], v1 = acc[ai][bj][m][1]; __VA_ARGS__ } \
      if (m & 1) asm volatile("" ::: "memory"); } } while (0)
#define EPI_FOR8T(...) do { const int row0_ = u.pm * 256 + wr * 64 + fr, col0_ = u.pn * 256 + wc * 32 + 8 * fq; \
    _Pragma("unroll") for (int ai = 0; ai < 2; ++ai) _Pragma("unroll") for (int m = 0; m < 4; ++m) { const size_t row = (size_t)(row0_ + ai * 128 + m * 16); \
      _Pragma("unroll") for (int bj = 0; bj < 2; ++bj) { const int col = col0_ + bj * 128; const f32x4 v0 = acc[ai][bj][m][0], v1 = acc[ai][bj][m][1]; __VA_ARGS__ } \
      asm volatile("" ::: "memory"); } } while (0)
#define EPI_HEAD_P static constexpr bool PERM = true, AFTER_DRAIN = false; \
  DI void operator()(const f32x4 (&acc)[2][2][4][2], const Unit& u, int wr, int wc, int fr, int fq) const
DI f32x4 sig4(f32x4 v) { f32x4 o; o[0] = sigmoidf(v[0]); o[1] = sigmoidf(v[1]); o[2] = sigmoidf(v[2]); o[3] = sigmoidf(v[3]); return o; }
struct EpiProjP { u16 *Q, *Kb, *VT, *ZR, *GT;
  EPI_HEAD_P {
    if (u.pn < 2) { EPI_FOR8( *(uint4*)(Q + row * 512 + col) = pack8(v0, v1); ); }
    else if (u.pn == 2) {
      EPI_FOR8( if (bj == 0) { *(uint4*)(Kb + row * 128 + (col - 512)) = pack8(v0, v1); }
                else { *(uint4*)(VT + row * 128 + (col - 640)) = pack8(v0, v1); } );
    }
    else if (u.pn < 10) { EPI_FOR8( *(uint4*)(ZR + row * 1792 + (col - 768)) = pack8(v0, v1); ); }
    else { EPI_FOR8( *(uint4*)(GT + row * 2048 + (col - 2560)) = pack8(sig4(v0), sig4(v1)); ); }
  } };
struct EpiRelu2P { u16* HID;
  EPI_HEAD_P { EPI_FOR8( f32x4 a, b;
                         a[0] = relu_raw(v0[0]); a[1] = relu_raw(v0[1]); a[2] = relu_raw(v0[2]); a[3] = relu_raw(v0[3]); a = a * a;
                         b[0] = relu_raw(v1[0]); b[1] = relu_raw(v1[1]); b[2] = relu_raw(v1[2]); b[3] = relu_raw(v1[3]); b = b * b;
                         *(uint4*)(HID + row * 4096 + col) = pack8(a, b); ); } };
struct EpiMergeCatP { u16* MG; const u16* GT;
  static constexpr bool PERM = true, AFTER_DRAIN = false;
  DI void mid(f32x4 (&acc)[2][2][4][2], const Unit& u, int wr, int wc, int fr, int fq) const {
    const int row0_ = u.pm * 256 + wr * 64 + fr, col0_ = u.pn * 256 + wc * 32 + 8 * fq;
#pragma unroll
    for (int ai = 0; ai < 2; ++ai)
#pragma unroll
      for (int m = 0; m < 4; ++m) {
        const size_t row = (size_t)(row0_ + ai * 128 + m * 16);
#pragma unroll
        for (int bj = 0; bj < 2; ++bj) {
          const int col = col0_ + bj * 128;
          float g0[8], g1[8];
          unpack8(*(const uint4*)(GT + row * 2048 + col), g0); unpack8(*(const uint4*)(GT + row * 2048 + 1024 + col), g1);
#pragma unroll
          for (int e = 0; e < 4; ++e) {
            acc[ai][bj][m][0][e] *= g0[e] * __builtin_amdgcn_rcpf(fmaxf(g1[e], 1e-20f));
            acc[ai][bj][m][1][e] *= g0[4 + e] * __builtin_amdgcn_rcpf(fmaxf(g1[4 + e], 1e-20f));
          }
        }
        asm volatile("" ::: "memory");
      }
  }
  DI void operator()(const f32x4 (&acc)[2][2][4][2], const Unit& u, int wr, int wc, int fr, int fq) const {
    EPI_FOR8T( float g1[8]; unpack8(*(const uint4*)(GT + row * 2048 + 1024 + col), g1); f32x4 a, b;
              a[0] = v0[0] * fmaxf(g1[0], 1e-20f); a[1] = v0[1] * fmaxf(g1[1], 1e-20f); a[2] = v0[2] * fmaxf(g1[2], 1e-20f); a[3] = v0[3] * fmaxf(g1[3], 1e-20f);
              b[0] = v1[0] * fmaxf(g1[4], 1e-20f); b[1] = v1[1] * fmaxf(g1[5], 1e-20f); b[2] = v1[2] * fmaxf(g1[6], 1e-20f); b[3] = v1[3] * fmaxf(g1[7], 1e-20f);
              *(uint4*)(MG + row * 1024 + col) = pack8(a, b); );
  } };
struct EpiStoreBfP { u16* O;
  EPI_HEAD_P { EPI_FOR8( *(uint4*)(O + row * 1024 + col) = pack8(v0, v1); ); } };
struct EpiResidP { float* out; const float* x;
  EPI_HEAD_P { EPI_FOR8( const float* xp = x + row * 1024 + col; float* op = out + row * 1024 + col;
                         const f32x4 r0 = *(const f32x4*)xp + v0, r1 = *(const f32x4*)(xp + 4) + v1; *(f32x4*)op = r0; *(f32x4*)(op + 4) = r1; ); } };
struct EpiPle2P { float* out; const u16* PE;
  EPI_HEAD_P { EPI_FOR8T( float pe[8]; unpack8(*(const uint4*)(PE + row * 1024 + col), pe); float* op = out + row * 1024 + col; f32x4 a, b;
                         a[0] = pe[0] * sigmoidf(v0[0]); a[1] = pe[1] * sigmoidf(v0[1]); a[2] = pe[2] * sigmoidf(v0[2]); a[3] = pe[3] * sigmoidf(v0[3]);
                         b[0] = pe[4] * sigmoidf(v1[0]); b[1] = pe[5] * sigmoidf(v1[1]); b[2] = pe[6] * sigmoidf(v1[2]); b[3] = pe[7] * sigmoidf(v1[3]);
                         *(f32x4*)op = *(const f32x4*)op + a; *(f32x4*)(op + 4) = *(const f32x4*)(op + 4) + b; ); } };
struct EpiProj { u16 *Q, *Kb, *VT, *ZR, *GT;
  EPI_HEAD {
    if (u.pn < 2) { EPI_FOR( *(uint2*)(Q + row * 512 + col) = pack4(v); ); }
    else if (u.pn == 2) {
      EPI_FOR( if (bj == 0) { *(uint2*)(Kb + row * 128 + (col - 512)) = pack4(v); }
               else { const int c = col - 640, kvh = c >> 6, d = c & 63, b = (int)(row >> 12), s = (int)(row & 4095);
                      u16* vp = VT + ((size_t)((b * 2 + kvh) * 64 + d)) * 4096 + s; const uint2 pk = pack4(v);
                      vp[0] = (u16)(pk.x & 0xffffu); vp[4096] = (u16)(pk.x >> 16); vp[8192] = (u16)(pk.y & 0xffffu); vp[12288] = (u16)(pk.y >> 16); } );
    }
    else if (u.pn < 10) { EPI_FOR( *(uint2*)(ZR + row * 1792 + (col - 768)) = pack4(v); ); }
    else { EPI_FOR( f32x4 sgm; sgm[0] = sigmoidf(v[0]); sgm[1] = sigmoidf(v[1]); sgm[2] = sigmoidf(v[2]); sgm[3] = sigmoidf(v[3]);
                    *(uint2*)(GT + row * 2048 + (col - 2560)) = pack4(sgm); ); }
  } };
struct EpiMerge1 { u16* MG; const u16* GT;
  EPI_HEAD { EPI_FOR( const uint2 g = *(const uint2*)(GT + row * 2048 + col); f32x4 o;
                      o[0] = v[0] * bflo(g.x); o[1] = v[1] * bfhi(g.x); o[2] = v[2] * bflo(g.y); o[3] = v[3] * bfhi(g.y);
                      *(uint2*)(MG + row * 1024 + col) = pack4(o); ); } };
struct EpiMerge2 { u16* MG; const u16* GT;
  EPI_HEAD { EPI_FOR( const uint2 g = *(const uint2*)(GT + row * 2048 + 1024 + col); const uint2 p = *(const uint2*)(MG + row * 1024 + col); f32x4 o;
                      o[0] = bflo(p.x) + v[0] * bflo(g.x); o[1] = bfhi(p.x) + v[1] * bfhi(g.x); o[2] = bflo(p.y) + v[2] * bflo(g.y); o[3] = bfhi(p.y) + v[3] * bfhi(g.y);
                      *(uint2*)(MG + row * 1024 + col) = pack4(o); ); } };
struct EpiMergeCat { u16* MG; const u16* GT;
  static constexpr bool PERM = false, AFTER_DRAIN = false;
  DI void mid(f32x4 (&acc)[2][2][4][2], const Unit& u, int wr, int wc, int fr, int fq) const {
    const int row0_ = u.pm * 256 + wr * 64 + fr, col0_ = u.pn * 256 + wc * 32 + 4 * fq;
#pragma unroll
    for (int ai = 0; ai < 2; ++ai)
#pragma unroll
      for (int m = 0; m < 4; ++m) {
        const size_t row = (size_t)(row0_ + ai * 128 + m * 16);
#pragma unroll
        for (int bj = 0; bj < 2; ++bj)
#pragma unroll
          for (int n = 0; n < 2; ++n) {
            const int col = col0_ + bj * 128 + n * 16;
            const uint2 g0 = *(const uint2*)(GT + row * 2048 + col), g1 = *(const uint2*)(GT + row * 2048 + 1024 + col);
            acc[ai][bj][m][n][0] *= bflo(g0.x) * __builtin_amdgcn_rcpf(fmaxf(bflo(g1.x), 1e-20f));
            acc[ai][bj][m][n][1] *= bfhi(g0.x) * __builtin_amdgcn_rcpf(fmaxf(bfhi(g1.x), 1e-20f));
            acc[ai][bj][m][n][2] *= bflo(g0.y) * __builtin_amdgcn_rcpf(fmaxf(bflo(g1.y), 1e-20f));
            acc[ai][bj][m][n][3] *= bfhi(g0.y) * __builtin_amdgcn_rcpf(fmaxf(bfhi(g1.y), 1e-20f));
          }
        if (m & 1) asm volatile("" ::: "memory");
      }
  }
  DI void operator()(const f32x4 (&acc)[2][2][4][2], const Unit& u, int wr, int wc, int fr, int fq) const {
    EPI_FOR( const uint2 g1 = *(const uint2*)(GT + row * 2048 + 1024 + col); f32x4 o;
             o[0] = v[0] * fmaxf(bflo(g1.x), 1e-20f); o[1] = v[1] * fmaxf(bfhi(g1.x), 1e-20f); o[2] = v[2] * fmaxf(bflo(g1.y), 1e-20f); o[3] = v[3] * fmaxf(bfhi(g1.y), 1e-20f);
             *(uint2*)(MG + row * 1024 + col) = pack4(o); );
  } };
struct EpiResid { float* out; const float* x;
  EPI_HEAD { EPI_FOR( *(f32x4*)(out + row * 1024 + col) = *(const f32x4*)(x + row * 1024 + col) + v; ); } };
struct EpiRelu2 { u16* HID;
  EPI_HEAD { EPI_FOR( f32x4 o; o[0] = fmaxf(v[0], 0.f); o[1] = fmaxf(v[1], 0.f); o[2] = fmaxf(v[2], 0.f); o[3] = fmaxf(v[3], 0.f); o = o * o;
                      *(uint2*)(HID + row * 4096 + col) = pack4(o); ); } };
struct EpiStoreBf { u16* O;
  EPI_HEAD { EPI_FOR( *(uint2*)(O + row * 1024 + col) = pack4(v); ); } };
struct EpiPle2 { float* out; const u16* PE;
  EPI_HEAD { EPI_FOR( const uint2 p = *(const uint2*)(PE + row * 1024 + col); f32x4 o;
                      o[0] = bflo(p.x) * sigmoidf(v[0]); o[1] = bfhi(p.x) * sigmoidf(v[1]); o[2] = bflo(p.y) * sigmoidf(v[2]); o[3] = bfhi(p.y) * sigmoidf(v[3]);
                      float* op = out + row * 1024 + col; *(f32x4*)op = *(const f32x4*)op + o; ); } };

template <class Epi> DI void run_gemm(char* smem, const u16* A, const u16* Bt, int N, int K, const Epi& E) {
  pg8::StaticOrder S; S.init(T, N, gridDim.x, blockIdx.x);
  pg8::Gemm g{A, Bt, T, N, K};
  pg8::gemm_phase<Epi, pg8::StaticOrder, false>((PG8_LAS unsigned char*)smem, g, S, E, nullptr);
}

template <class Epi> DI void run_gemm_cat(char* smem, const u16* A1, const u16* B1, const u16* A2, const u16* B2, int N, int K, const Epi& E) {
  pg8::StaticOrder S; S.init(T, N, gridDim.x, blockIdx.x);
  pg8::Gemm g{A1, B1, T, N, K};
  pg8::gemm_phase_cat<Epi, pg8::StaticOrder, false>((PG8_LAS unsigned char*)smem, g, A2, B2, S, E, nullptr);
}

DI void p1_proj(const Params& P, char* smem) {
  EpiProjP E{(u16*)(P.ws + QKV_OFF), (u16*)(P.ws + K_OFF), (u16*)(P.ws + VT_OFF), (u16*)(P.ws + ZR_OFF), (u16*)(P.ws + GATES_OFF)};
  run_gemm(smem, (const u16*)P.out, (const u16*)P.ws + WT_IN, 4608, 1024, E);
}

#define MFMA16(a, b, c) __builtin_amdgcn_mfma_f32_16x16x32_bf16((a), (b), (c), 0, 0, 0)
constexpr int LDT = 72;
DI void norm_row_to_lds(const u16* srow, bool valid, const float* gain, const float* ROT, int pos, float scale, u16* drow, int quarter) {
  uint4 o0 = make_uint4(0u, 0u, 0u, 0u), o1 = o0;
  uint4 a0 = o0, a1 = o0;
  if (valid) { a0 = *(const uint4*)(srow + quarter * 16); a1 = *(const uint4*)(srow + quarter * 16 + 8); }
  unsigned uu[8] = {a0.x, a0.y, a0.z, a0.w, a1.x, a1.y, a1.z, a1.w};
  float x[16]; float ss = 0.f;
#pragma unroll
  for (int e = 0; e < 8; ++e) { x[2 * e] = __uint_as_float(uu[e] << 16); x[2 * e + 1] = __uint_as_float(uu[e] & 0xffff0000u); ss += x[2 * e] * x[2 * e] + x[2 * e + 1] * x[2 * e + 1]; }
  ss += __shfl_xor(ss, 1); ss += __shfl_xor(ss, 2);
  const float sc = rsqrtf(ss * (1.f / 64.f) + 1e-6f);
  const float4* g4 = (const float4*)(gain + quarter * 16);
#pragma unroll
  for (int e = 0; e < 4; ++e) { float4 g = g4[e]; x[4 * e] *= sc * g.x; x[4 * e + 1] *= sc * g.y; x[4 * e + 2] *= sc * g.z; x[4 * e + 3] *= sc * g.w; }
  if (quarter == 0 && valid) {
    const float4* c4 = (const float4*)(ROT + pos * 8); const float4* s4 = (const float4*)(ROT + 32768 + pos * 8);
    float4 ca = c4[0], cb = c4[1], sa = s4[0], sb = s4[1];
    float cs[8] = {ca.x, ca.y, ca.z, ca.w, cb.x, cb.y, cb.z, cb.w}, sn[8] = {sa.x, sa.y, sa.z, sa.w, sb.x, sb.y, sb.z, sb.w};
#pragma unroll
    for (int e = 0; e < 8; ++e) { float x1 = x[e], x2 = x[e + 8]; x[e] = x1 * cs[e] - x2 * sn[e]; x[e + 8] = x2 * cs[e] + x1 * sn[e]; }
  }
  if (valid) {
    o0 = make_uint4(pack2(x[0] * scale, x[1] * scale), pack2(x[2] * scale, x[3] * scale), pack2(x[4] * scale, x[5] * scale), pack2(x[6] * scale, x[7] * scale));
    o1 = make_uint4(pack2(x[8] * scale, x[9] * scale), pack2(x[10] * scale, x[11] * scale), pack2(x[12] * scale, x[13] * scale), pack2(x[14] * scale, x[15] * scale));
  }
  *(uint4*)(drow + quarter * 16) = o0; *(uint4*)(drow + quarter * 16 + 8) = o1;
}

constexpr int VTS = 392;
DI void p2_attn(const Params& P, char* smem) {
  const int tid = tid_fresh(), lane = tid & 63, w = tid >> 6;
  u16* Ks = (u16*)smem;
  u16* Vt = Ks + 384 * LDT;
  u16* Qs = Vt + 64 * VTS;
  const u16* Q = (const u16*)(P.ws + QKV_OFF); const u16* Kb = (const u16*)(P.ws + K_OFF); const u16* VT = (const u16*)(P.ws + VT_OFF);
  const float* ROT = (const float*)(P.ws + ROT_OFF);
  u16* AT = (u16*)(P.ws + ATTN_OFF);
  const int fr = lane & 15, fg = lane >> 4;
  for (int bi = blockIdx.x; bi < 256; bi += gridDim.x) {
    const int kvh = bi & 1, qblk = (bi >> 1) & 31, b = bi >> 6;
    const int kbase = qblk * 128 - 128;
#pragma unroll 1
    for (int ps = 0; ps < 3; ++ps) {
      const int rowl = ps * 128 + (tid >> 2), kp = kbase + rowl;
      const bool valid = kp >= 0 && kp < S;
      norm_row_to_lds(Kb + (size_t)(b * S + (valid ? kp : 0)) * 128 + kvh * 64, valid, P.k_norm, ROT, kp, 1.0f, Ks + rowl * LDT, tid & 3);
    }
#pragma unroll 2
    for (int i = 0; i < 6; ++i) {
      const int c = i * NTHR + tid, key = c % 384, dq = (c / 384) * 8, kp = kbase + key;
      uint4 v = make_uint4(0u, 0u, 0u, 0u);
      if (kp >= 0 && kp < S) v = *(const uint4*)(VT + (size_t)(b * S + kp) * 128 + kvh * 64 + dq);
      u16* vp = Vt + dq * VTS + key;
      vp[0] = (u16)(v.x & 0xffffu); vp[VTS] = (u16)(v.x >> 16); vp[2 * VTS] = (u16)(v.y & 0xffffu); vp[3 * VTS] = (u16)(v.y >> 16);
      vp[4 * VTS] = (u16)(v.z & 0xffffu); vp[5 * VTS] = (u16)(v.z >> 16); vp[6 * VTS] = (u16)(v.w & 0xffffu); vp[7 * VTS] = (u16)(v.w >> 16);
    }
#pragma unroll 1
    for (int g = 0; g < 4; ++g) {
      const int qh = kvh * 4 + g;
      {
        const int rowl = tid >> 2, qp = qblk * 128 + rowl;
        norm_row_to_lds(Q + (size_t)(b * S + qp) * 512 + qh * 64, true, P.q_norm, ROT, qp, 0.125f * 1.44269504f, Qs + rowl * LDT, tid & 3);
      }
      __syncthreads();
      const int qw = w * 16;
      bf16x8 bq0 = *(const bf16x8*)(Qs + (qw + fr) * LDT + fg * 8);
      bf16x8 bq1 = *(const bf16x8*)(Qs + (qw + fr) * LDT + 32 + fg * 8);
      f32x4 st[17];
#pragma unroll
      for (int i = 0; i < 17; ++i) {
        const bf16x8 ak0 = *(const bf16x8*)(Ks + ((w + i) * 16 + fr) * LDT + fg * 8);
        const bf16x8 ak1 = *(const bf16x8*)(Ks + ((w + i) * 16 + fr) * LDT + 32 + fg * 8);
        f32x4 z = {0.f, 0.f, 0.f, 0.f};
        z = MFMA16(ak0, bq0, z);
        st[i] = MFMA16(ak1, bq1, z);
        if ((i & 3) == 3) __builtin_amdgcn_sched_barrier(0);
      }
#pragma unroll
      for (int r = 0; r < 4; ++r) {
        st[0][r] = (fg * 4 + r >= fr) ? st[0][r] : -1e30f;
        st[16][r] = (fg * 4 + r <= fr) ? st[16][r] : -1e30f;
      }
      if (qblk == 0 || qblk == 31) {
#pragma unroll
        for (int i = 0; i < 17; ++i) {
          const int kt = w + i;
          const float pen = ((qblk == 0 && kt < 8) || (qblk == 31 && kt >= 16)) ? -1e30f : 0.f;
#pragma unroll
          for (int r = 0; r < 4; ++r) st[i][r] += pen;
        }
      }
      float m = -1e30f;
#pragma unroll
      for (int i = 0; i < 17; ++i) { m = vmax3_raw(m, st[i][0], st[i][1]); m = vmax3_raw(m, st[i][2], st[i][3]); }
      m = vmax_raw(m, __shfl_xor(m, 16)); m = vmax_raw(m, __shfl_xor(m, 32));
      const float sk = P.sink[qh] * 1.44269504f;
      m = fmaxf(m, sk);
      float l = 0.f;
#pragma unroll
      for (int i = 0; i < 17; ++i)
#pragma unroll
        for (int r = 0; r < 4; ++r) {
          const float pv = __builtin_amdgcn_exp2f(st[i][r] - m);
          st[i][r] = pv; l += pv;
        }
      l += __shfl_xor(l, 16); l += __shfl_xor(l, 32);
      l += __builtin_amdgcn_exp2f(sk - m);
      const float invl = __builtin_amdgcn_rcpf(l);
      f32x4 ot[4];
#pragma unroll
      for (int dt = 0; dt < 4; ++dt) ot[dt] = f32x4{0.f, 0.f, 0.f, 0.f};
#pragma unroll
      for (int c = 0; c < 9; ++c) {
        union { unsigned u[4]; bf16x8 v; } pb;
        pb.u[0] = pack2(st[2 * c][0], st[2 * c][1]); pb.u[1] = pack2(st[2 * c][2], st[2 * c][3]);
        if (c < 8) { pb.u[2] = pack2(st[2 * c + 1][0], st[2 * c + 1][1]); pb.u[3] = pack2(st[2 * c + 1][2], st[2 * c + 1][3]); }
        else { pb.u[2] = 0u; pb.u[3] = 0u; }
        const int k0 = (w + 2 * c) * 16 + fg * 4, k1 = min(w + 2 * c + 1, 23) * 16 + fg * 4;
#pragma unroll
        for (int dt = 0; dt < 4; ++dt) {
          union { uint2 h[2]; bf16x8 v; } av;
          const int vrow = 32 * (dt >> 1) + 8 * (fr >> 2) + 4 * (dt & 1) + (fr & 3);
          av.h[0] = *(const uint2*)(Vt + vrow * VTS + k0);
          av.h[1] = *(const uint2*)(Vt + vrow * VTS + k1);
          ot[dt] = MFMA16(av.v, pb.v, ot[dt]);
        }
        __builtin_amdgcn_sched_barrier(0);
      }
      const size_t tok = (size_t)(b * S + qblk * 128 + qw + fr);
#pragma unroll
      for (int g2 = 0; g2 < 2; ++g2) {
        uint4 o;
        o.x = pack2(ot[2 * g2][0] * invl, ot[2 * g2][1] * invl); o.y = pack2(ot[2 * g2][2] * invl, ot[2 * g2][3] * invl);
        o.z = pack2(ot[2 * g2 + 1][0] * invl, ot[2 * g2 + 1][1] * invl); o.w = pack2(ot[2 * g2 + 1][2] * invl, ot[2 * g2 + 1][3] * invl);
        *(uint4*)(AT + tok * 512 + qh * 64 + g2 * 32 + fg * 8) = o;
      }
      __syncthreads();
    }
  }
}

template <int MODE>
DI void stage_shift128(const u16* ZR, const float* shift_mu, int t0, int zc0, u16* dst, int ldr) {
  const int tid = tid_fresh(), tt = tid >> 3, cg = (tid & 7) * 16, t = t0 + tt, s = t & 4095;
  const u16* zp = ZR + (size_t)t * 1792 + zc0 + cg;
  uint4 c0 = *(const uint4*)zp, c1 = *(const uint4*)(zp + 8), p0 = make_uint4(0u, 0u, 0u, 0u), p1 = p0, n0 = p0, n1 = p0;
  if (s > 0) { p0 = *(const uint4*)(zp - 1792); p1 = *(const uint4*)(zp - 1792 + 8); }
  if (s < S - 1) { n0 = *(const uint4*)(zp + 1792); n1 = *(const uint4*)(zp + 1792 + 8); }
  const unsigned cw[8] = {c0.x, c0.y, c0.z, c0.w, c1.x, c1.y, c1.z, c1.w}, pw[8] = {p0.x, p0.y, p0.z, p0.w, p1.x, p1.y, p1.z, p1.w},
                 nw[8] = {n0.x, n0.y, n0.z, n0.w, n1.x, n1.y, n1.z, n1.w};
  const float4* mu4 = (const float4*)(shift_mu + zc0 + cg);
  unsigned ow[8];
#pragma unroll
  for (int q = 0; q < 4; ++q) {
    const float4 mu = mu4[q];
    float val[4];
#pragma unroll
    for (int e = 0; e < 4; ++e) {
      const int wi = q * 2 + (e >> 1);
      const float z = (e & 1) ? bfhi(cw[wi]) : bflo(cw[wi]), pv = (e & 1) ? bfhi(pw[wi]) : bflo(pw[wi]), nx = (e & 1) ? bfhi(nw[wi]) : bflo(nw[wi]);
      const float m_ = e == 0 ? mu.x : e == 1 ? mu.y : e == 2 ? mu.z : mu.w;
      float x = z + m_ * (0.5f * (pv + nx) - z);
      if (MODE == 1) x = sigmoidf(x);
      else if (cg < 64) { const float e2 = __expf(2.f * x); x = 1.f - 2.f * __builtin_amdgcn_rcpf(e2 + 1.f); }
      val[e] = x;
    }
    ow[q * 2] = pack2(val[0], val[1]); ow[q * 2 + 1] = pack2(val[2], val[3]);
  }
  *(uint4*)(dst + tt * ldr + cg) = make_uint4(ow[0], ow[1], ow[2], ow[3]);
  *(uint4*)(dst + tt * ldr + cg + 8) = make_uint4(ow[4], ow[5], ow[6], ow[7]);
}
DI bf16x8 bfrag_from_f32(const float* Wm, int k0, int c) {
  union { unsigned u[4]; bf16x8 v; } r;
#pragma unroll
  for (int j = 0; j < 4; ++j) r.u[j] = pack2(Wm[(size_t)(k0 + 2 * j) * 512 + c], Wm[(size_t)(k0 + 2 * j + 1) * 512 + c]);
  return r.v;
}
DI void p2_prep(const Params& P, char* smem) {
  const int tid = tid_fresh(), lane = tid & 63, w = tid >> 6, fr = lane & 15, fq = lane >> 4;
  u16* As = (u16*)smem;
  const u16* ZR = (const u16*)(P.ws + ZR_OFF);
  u16* SW = (u16*)P.out; u16* AA = SW + (size_t)2 * T * 512;
  const int c0 = w * 64;
  for (int tile = blockIdx.x; tile < T / 64; tile += gridDim.x) {
    const int t0 = tile * 64;
    stage_shift128<0>(ZR, P.shift_mu, t0, 1536, As, 136);
    __syncthreads();
#pragma unroll 1
    for (int mat = 0; mat < 4; ++mat) {
      const int d = mat >> 1, isa = mat & 1;
      const u16* Wt = (const u16*)(P.ws + W2T_OFF) + (size_t)mat * 512 * 64;
      f32x4 acc[4][4];
#pragma unroll
      for (int m = 0; m < 4; ++m)
#pragma unroll
        for (int n = 0; n < 4; ++n) acc[m][n] = f32x4{0.f, 0.f, 0.f, 0.f};
#pragma unroll
      for (int ks = 0; ks < 2; ++ks) {
        bf16x8 bf[4], af[4];
#pragma unroll
        for (int n = 0; n < 4; ++n)
          bf[n] = *(const bf16x8*)(Wt + (size_t)(c0 + (n >> 1) * 32 + 8 * (fr >> 2) + 4 * (n & 1) + (fr & 3)) * 64 + ks * 32 + fq * 8);
#pragma unroll
        for (int m = 0; m < 4; ++m) af[m] = *(const bf16x8*)(As + (m * 16 + fr) * 136 + isa * 64 + ks * 32 + fq * 8);
#pragma unroll
        for (int m = 0; m < 4; ++m)
#pragma unroll
          for (int n = 0; n < 4; ++n) acc[m][n] = MFMA16(bf[n], af[m], acc[m][n]);
      }
      u16* O = (isa ? AA : SW) + (size_t)d * T * 512;
      const float* bias = (isa ? P.a0 : P.w0) + d * 512;
      const float mul = isa ? 1.f : 0.60653066f;
#pragma unroll
      for (int g = 0; g < 2; ++g) {
        const int c = c0 + g * 32 + 8 * fq;
        const float4 b0 = *(const float4*)(bias + c), b1 = *(const float4*)(bias + c + 4);
#pragma unroll
        for (int m = 0; m < 4; ++m) {
          f32x4 o0, o1;
          o0[0] = mul * sigmoidf(acc[m][2 * g][0] + b0.x); o0[1] = mul * sigmoidf(acc[m][2 * g][1] + b0.y);
          o0[2] = mul * sigmoidf(acc[m][2 * g][2] + b0.z); o0[3] = mul * sigmoidf(acc[m][2 * g][3] + b0.w);
          o1[0] = mul * sigmoidf(acc[m][2 * g + 1][0] + b1.x); o1[1] = mul * sigmoidf(acc[m][2 * g + 1][1] + b1.y);
          o1[2] = mul * sigmoidf(acc[m][2 * g + 1][2] + b1.z); o1[3] = mul * sigmoidf(acc[m][2 * g + 1][3] + b1.w);
          if (!isa) {
#pragma unroll
            for (int e = 0; e < 4; ++e) { o0[e] = 1.f - __expf(-o0[e]); o1[e] = 1.f - __expf(-o1[e]); }
          }
          *(uint4*)(O + (size_t)(t0 + m * 16 + fr) * 512 + c) = pack8(o0, o1);
        }
      }
    }
    __syncthreads();
  }
}

constexpr int SCB = 5 * 2048 + 512 + 512;
struct ScanRaw { uint2 c[3], p[3], n[3], sw, aa; };
DI void scan_load(ScanRaw& R, const u16* ZR, const u16* SW, const u16* AA, int d, int b, int h, int ci, int pj, int pc) {
  const int step = ci * 32 + pj, s = d ? (S - 1 - step) : step, t = b * S + s;
  const u16* zp = ZR + (size_t)t * 1792 + h * 64 + pc;
#pragma unroll
  for (int g = 0; g < 3; ++g) {
    R.c[g] = *(const uint2*)(zp + g * 512);
    R.p[g] = s > 0 ? *(const uint2*)(zp + g * 512 - 1792) : make_uint2(0u, 0u);
    R.n[g] = s < S - 1 ? *(const uint2*)(zp + g * 512 + 1792) : make_uint2(0u, 0u);
  }
  R.sw = *(const uint2*)(SW + ((size_t)d * T + t) * 512 + h * 64 + pc);
  R.aa = *(const uint2*)(AA + ((size_t)d * T + t) * 512 + h * 64 + pc);
}
DI void scan_process(const ScanRaw& R, float* buf, int rq, int pj, int pc,
                     const float (&mur)[4], const float (&muk)[4], const float (&muv)[4], const float (&kkw)[4], const float (&kaw)[4]) {
  float rr[4], kk[4], vv[4];
#pragma unroll
  for (int g = 0; g < 3; ++g) {
    const unsigned cw[2] = {R.c[g].x, R.c[g].y}, pw[2] = {R.p[g].x, R.p[g].y}, nw2[2] = {R.n[g].x, R.n[g].y};
#pragma unroll
    for (int e = 0; e < 4; ++e) {
      const float z = (e & 1) ? bfhi(cw[e >> 1]) : bflo(cw[e >> 1]);
      const float pv = (e & 1) ? bfhi(pw[e >> 1]) : bflo(pw[e >> 1]);
      const float nx = (e & 1) ? bfhi(nw2[e >> 1]) : bflo(nw2[e >> 1]);
      const float mu = g == 0 ? mur[e] : g == 1 ? muk[e] : muv[e];
      const float val = z + mu * (0.5f * (pv + nx) - z);
      if (g == 0) rr[e] = val; else if (g == 1) kk[e] = val; else vv[e] = val;
    }
  }
  const unsigned sw2[2] = {R.sw.x, R.sw.y}, aw2[2] = {R.aa.x, R.aa.y};
  float kq[4], n2 = 0.f;
#pragma unroll
  for (int e = 0; e < 4; ++e) { kq[e] = kk[e] * kkw[e]; n2 += kq[e] * kq[e]; }
  n2 = row16_sum(n2);
  const float inv = fminf(__builtin_amdgcn_rsqf(n2), 1e12f);
  float tna[4], tw_[4], tb[4], tkd[4];
#pragma unroll
  for (int e = 0; e < 4; ++e) {
    const float sg = (e & 1) ? bfhi(sw2[e >> 1]) : bflo(sw2[e >> 1]);
    const float a = (e & 1) ? bfhi(aw2[e >> 1]) : bflo(aw2[e >> 1]);
    const float kn = kq[e] * inv;
    tna[e] = -kn; tw_[e] = 1.f - sg; tb[e] = kn * a; tkd[e] = kk[e] * (1.f + (a - 1.f) * kaw[e]);
  }
  float* NA = buf; float* Wd = NA + 2048; float* Bv = Wd + 2048; float* KD = Bv + 2048; float* Rr = KD + 2048; float* Vv = Rr + 2048;
  *(float4*)(NA + pj * 64 + pc) = make_float4(tna[0], tna[1], tna[2], tna[3]);
  *(float4*)(Wd + pj * 64 + pc) = make_float4(tw_[0], tw_[1], tw_[2], tw_[3]);
  *(float4*)(Bv + pj * 64 + pc) = make_float4(tb[0], tb[1], tb[2], tb[3]);
  *(float4*)(KD + pj * 64 + pc) = make_float4(tkd[0], tkd[1], tkd[2], tkd[3]);
  *(float4*)(Rr + pj * 64 + pc) = make_float4(rr[0], rr[1], rr[2], rr[3]);
  if ((pc >> 4) == rq) *(float4*)(Vv + pj * 16 + (pc & 15)) = make_float4(vv[0], vv[1], vv[2], vv[3]);
}
DI void p3_scan(const Params& P, char* smem) {
  const int tid = tid_fresh(), lane = tid & 63, w = tid >> 6;
  float* bufs = (float*)smem;
  const u16* ZR = (const u16*)(P.ws + ZR_OFF);
  const u16* SW = (const u16*)P.out; const u16* AA = SW + (size_t)2 * T * 512;
  u16* Y = (u16*)(P.ws + Y_OFF);
  for (int item = blockIdx.x; item < 256; item += gridDim.x) {
    const int u = (item & 7) * 8 + (item >> 5), rq = (item >> 3) & 3;
    const int d = u >> 5, b = (u >> 3) & 3, h = u & 7;
    if (w >= 4) {
      const int lt = tid & 255, pj = lt >> 4, pc = (lt & 15) * 4;
      float mur[4], muk[4], muv[4], kkw[4], kaw[4];
#pragma unroll
      for (int e = 0; e < 4; ++e) {
        mur[e] = P.shift_mu[h * 64 + pc + e]; muk[e] = P.shift_mu[512 + h * 64 + pc + e]; muv[e] = P.shift_mu[1024 + h * 64 + pc + e];
        kkw[e] = P.k_k[h * 64 + pc + e]; kaw[e] = P.k_a[h * 64 + pc + e];
      }
      ScanRaw r0, r1;
      scan_load(r0, ZR, SW, AA, d, b, h, 0, pj, pc); scan_load(r1, ZR, SW, AA, d, b, h, 0, pj + 16, pc);
      scan_process(r0, bufs, rq, pj, pc, mur, muk, muv, kkw, kaw); scan_process(r1, bufs, rq, pj + 16, pc, mur, muk, muv, kkw, kaw);
      scan_load(r0, ZR, SW, AA, d, b, h, 1, pj, pc); scan_load(r1, ZR, SW, AA, d, b, h, 1, pj + 16, pc);
      __syncthreads();
      for (int ci = 0; ci < 128; ++ci) {
        if (ci + 1 < 128) {
          float* nxt = bufs + ((ci + 1) & 1) * SCB;
          scan_process(r0, nxt, rq, pj, pc, mur, muk, muv, kkw, kaw); scan_process(r1, nxt, rq, pj + 16, pc, mur, muk, muv, kkw, kaw);
          if (ci + 2 < 128) { scan_load(r0, ZR, SW, AA, d, b, h, ci + 2, pj, pc); scan_load(r1, ZR, SW, AA, d, b, h, ci + 2, pj + 16, pc); }
        }
        if (ci > 0) {
          const float* YSp = bufs + ((ci - 1) & 1) * SCB + 5 * 2048 + 512;
          if (lt < 64) {
            const int step = (ci - 1) * 32 + (lt >> 1), s = d ? (S - 1 - step) : step, t = b * S + s;
            const float4 ya = *(const float4*)(YSp + lt * 8), yb = *(const float4*)(YSp + lt * 8 + 4);
            *(uint4*)(Y + ((size_t)d * T + t) * 512 + h * 64 + rq * 16 + (lt & 1) * 8) = make_uint4(pack2(ya.x, ya.y), pack2(ya.z, ya.w), pack2(yb.x, yb.y), pack2(yb.z, yb.w));
          }
        }
        __syncthreads();
      }
      {
        const float* YSp = bufs + (127 & 1) * SCB + 5 * 2048 + 512;
        if (lt < 64) {
          const int step = 127 * 32 + (lt >> 1), s = d ? (S - 1 - step) : step, t = b * S + s;
          const float4 ya = *(const float4*)(YSp + lt * 8), yb = *(const float4*)(YSp + lt * 8 + 4);
          *(uint4*)(Y + ((size_t)d * T + t) * 512 + h * 64 + rq * 16 + (lt & 1) * 8) = make_uint4(pack2(ya.x, ya.y), pack2(ya.z, ya.w), pack2(yb.x, yb.y), pack2(yb.z, yb.w));
        }
      }
    } else {
      __builtin_amdgcn_s_setprio(2);
      const int rl = w * 4 + (lane >> 4), jl = lane & 15;
      f32x2v sA = {0.f, 0.f}, sB = {0.f, 0.f};
      __syncthreads();
      for (int ci = 0; ci < 128; ++ci) {
        const float* cur = bufs + (ci & 1) * SCB;
        const float* NA = cur + jl * 4; const float* Vv = cur + 5 * 2048 + rl;
        float yk0 = 0.f, yk1 = 0.f;
        float4 qna[3], qw[3], qb[3], qk[3], qr[3]; float qv[3];
#pragma unroll
        for (int p = 0; p < 2; ++p) {
          qna[p] = *(const float4*)(NA + p * 64); qw[p] = *(const float4*)(NA + 2048 + p * 64); qb[p] = *(const float4*)(NA + 4096 + p * 64);
          qk[p] = *(const float4*)(NA + 6144 + p * 64); qr[p] = *(const float4*)(NA + 8192 + p * 64); qv[p] = Vv[p * 16];
        }
#pragma unroll
        for (int j = 0; j < 32; ++j) {
          if (j + 2 < 32) {
            const int sn = (j + 2) % 3;
            qna[sn] = *(const float4*)(NA + (j + 2) * 64); qw[sn] = *(const float4*)(NA + 2048 + (j + 2) * 64); qb[sn] = *(const float4*)(NA + 4096 + (j + 2) * 64);
            qk[sn] = *(const float4*)(NA + 6144 + (j + 2) * 64); qr[sn] = *(const float4*)(NA + 8192 + (j + 2) * 64); qv[sn] = Vv[(j + 2) * 16];
          }
          __builtin_amdgcn_sched_barrier(7);
          const int sl = j % 3;
          const float4 na = qna[sl], wv = qw[sl], bv = qb[sl], kd = qk[sl], rv = qr[sl]; const float v = qv[sl];
          const f32x2v naA = {na.x, na.y}, naB = {na.z, na.w}, wA = {wv.x, wv.y}, wB = {wv.z, wv.w}, bA = {bv.x, bv.y}, bB = {bv.z, bv.w};
          const f32x2v kA = {kd.x, kd.y}, kB = {kd.z, kd.w}, rA = {rv.x, rv.y}, rB = {rv.z, rv.w};
          const f32x2v pp = sA * naA + sB * naB;
          float pa = pp.x + pp.y;
          const f32x2v vv2 = {v, v};
          const f32x2v uA = sA * wA + vv2 * kA, uB = sB * wB + vv2 * kB;
          pa = row16_sum(pa);
          asm volatile("" : "+v"(pa));
          const f32x2v pav = {pa, pa};
          sA = pav * bA + uA; sB = pav * bB + uB;
          const f32x2v qq = sA * rA + sB * rB;
          const float py = row16_sum(qq.x + qq.y);
          if (j < 16) yk0 = (jl == j) ? py : yk0; else yk1 = (jl == j - 16) ? py : yk1;
        }
        float* YS = bufs + (ci & 1) * SCB + 5 * 2048 + 512;
        YS[jl * 16 + rl] = yk0; YS[(16 + jl) * 16 + rl] = yk1;
        __syncthreads();
      }
      __builtin_amdgcn_s_setprio(0);
    }
    __syncthreads();
  }
}

DI float4 shift4(const u16* zp, int s, const float4 mu) {
  const uint2 c = *(const uint2*)zp;
  uint2 p = make_uint2(0u, 0u), n = p;
  if (s > 0) p = *(const uint2*)(zp - 1792);
  if (s < S - 1) n = *(const uint2*)(zp + 1792);
  float4 o;
  { const float z = bflo(c.x); o.x = z + mu.x * (0.5f * (bflo(p.x) + bflo(n.x)) - z); }
  { const float z = bfhi(c.x); o.y = z + mu.y * (0.5f * (bfhi(p.x) + bfhi(n.x)) - z); }
  { const float z = bflo(c.y); o.z = z + mu.z * (0.5f * (bflo(p.y) + bflo(n.y)) - z); }
  { const float z = bfhi(c.y); o.w = z + mu.w * (0.5f * (bfhi(p.y) + bfhi(n.y)) - z); }
  return o;
}
DI void shift8_dpp(const u16* zp, int s, int fr, const float* mu, float (&o)[8]) {
  const uint4 c = *(const uint4*)zp;
  uint4 pe = make_uint4(0u, 0u, 0u, 0u), ne = pe;
  if (fr == 0 && s > 0) pe = *(const uint4*)(zp - 1792);
  if (fr == 15 && s < S - 1) ne = *(const uint4*)(zp + 1792);
  const unsigned cw[4] = {c.x, c.y, c.z, c.w}, pw[4] = {pe.x, pe.y, pe.z, pe.w}, nw[4] = {ne.x, ne.y, ne.z, ne.w};
  const float4 m0 = *(const float4*)mu, m1 = *(const float4*)(mu + 4);
  const float mm[8] = {m0.x, m0.y, m0.z, m0.w, m1.x, m1.y, m1.z, m1.w};
#pragma unroll
  for (int q = 0; q < 4; ++q) {
    const unsigned p = (unsigned)__builtin_amdgcn_update_dpp((int)pw[q], (int)cw[q], 0x111, 0xF, 0xF, false);
    const unsigned n = (unsigned)__builtin_amdgcn_update_dpp((int)nw[q], (int)cw[q], 0x101, 0xF, 0xF, false);
    { const float z = bflo(cw[q]); o[2 * q] = z + mm[2 * q] * (0.5f * (bflo(p) + bflo(n)) - z); }
    { const float z = bfhi(cw[q]); o[2 * q + 1] = z + mm[2 * q + 1] * (0.5f * (bfhi(p) + bfhi(n)) - z); }
  }
}
DI void ld8(const float* p, float (&o)[8]) { const float4 a = *(const float4*)p, b = *(const float4*)(p + 4); o[0] = a.x; o[1] = a.y; o[2] = a.z; o[3] = a.w; o[4] = b.x; o[5] = b.y; o[6] = b.z; o[7] = b.w; }
DI void final_rows(const float* PT, const u16* ZR, const u16* AA, const u16* Y, u16* RW, const u16* grow, int t, int c0, int fq, int fr) {
  const int s = t & 4095;
  int cb = c0 + 8 * fq;
  asm volatile("" : "+v"(cb));
  float yv[2][8], vv[2][8];
  float sy = 0.f, sb = 0.f;
#pragma unroll
  for (int g = 0; g < 2; ++g) {
    const int c = cb + g * 32;
    float y0[8], y1[8];
    unpack8(*(const uint4*)(Y + (size_t)t * 512 + c), y0); unpack8(*(const uint4*)(Y + ((size_t)T + t) * 512 + c), y1);
    const u16* zp = ZR + (size_t)t * 1792 + c;
    float r[8], k[8];
    shift8_dpp(zp, s, fr, PT + c, r); shift8_dpp(zp + 512, s, fr, PT + 512 + c, k); shift8_dpp(zp + 1024, s, fr, PT + 1024 + c, vv[g]);
    float a0[8], a1[8], ka[8], rk0[8], rk1[8];
    unpack8(*(const uint4*)(AA + (size_t)t * 512 + c), a0); unpack8(*(const uint4*)(AA + ((size_t)T + t) * 512 + c), a1);
    ld8(PT + 1536 + c, ka); ld8(PT + 2048 + c, rk0); ld8(PT + 2560 + c, rk1);
#pragma unroll
    for (int e = 0; e < 8; ++e) {
      yv[g][e] = y0[e] + y1[e]; sy += yv[g][e];
      sb += r[e] * k[e] * ((1.f + (a0[e] - 1.f) * ka[e]) * rk0[e] + (1.f + (a1[e] - 1.f) * ka[e]) * rk1[e]);
    }
  }
  sy += __shfl_xor(sy, 16); sy += __shfl_xor(sy, 32);
  sb += __shfl_xor(sb, 16); sb += __shfl_xor(sb, 32);
  const float mu = sy * (1.f / 64.f);
  float sv = 0.f;
#pragma unroll
  for (int g = 0; g < 2; ++g)
#pragma unroll
    for (int e = 0; e < 8; ++e) { yv[g][e] -= mu; sv += yv[g][e] * yv[g][e]; }
  sv += __shfl_xor(sv, 16); sv += __shfl_xor(sv, 32);
  const float rstd = rsqrtf(sv * (1.f / 64.f) + 64e-5f);
#pragma unroll
  for (int g = 0; g < 2; ++g) {
    const int c = cb + g * 32;
    float lw[8], lb[8], gg[8];
    ld8(PT + 3072 + c, lw); ld8(PT + 3584 + c, lb); unpack8(*(const uint4*)(grow + g * 32), gg);
    f32x4 o0, o1;
#pragma unroll
    for (int e = 0; e < 4; ++e) {
      o0[e] = (yv[g][e] * rstd * lw[e] + lb[e] + sb * vv[g][e]) * gg[e];
      o1[e] = (yv[g][4 + e] * rstd * lw[4 + e] + lb[4 + e] + sb * vv[g][4 + e]) * gg[4 + e];
    }
    *(uint4*)(RW + (size_t)t * 512 + c) = pack8(o0, o1);
  }
  __builtin_amdgcn_sched_barrier(0);
}
DI void p4_final(const Params& P, char* smem) {
  const int tid = tid_fresh(), lane = tid & 63, w = tid >> 6, fr = lane & 15, fq = lane >> 4;
  u16* As = (u16*)smem;
  u16* Gs = As + 64 * 136;
  float* PT = (float*)(smem + 83968);
  const u16* ZR = (const u16*)(P.ws + ZR_OFF);
  const u16* AA = (const u16*)P.out + (size_t)2 * T * 512;
  const u16* Y = (const u16*)(P.ws + Y_OFF);
  u16* RW = (u16*)(P.ws + RW_OFF);
  const int c0 = w * 64;
  PT[tid] = P.shift_mu[tid]; PT[512 + tid] = P.shift_mu[512 + tid]; PT[1024 + tid] = P.shift_mu[1024 + tid]; PT[1536 + tid] = P.k_a[tid];
  PT[2048 + tid] = P.r_k[tid]; PT[2560 + tid] = P.r_k[512 + tid]; PT[3072 + tid] = P.lnx_w[tid]; PT[3584 + tid] = P.lnx_b[tid];
  for (int tile = blockIdx.x; tile < T / 64; tile += gridDim.x) {
    const int t0 = tile * 64;
    stage_shift128<1>(ZR, P.shift_mu, t0, 1664, As, 136);
    __syncthreads();
#pragma unroll 1
    for (int nh = 0; nh < 2; ++nh) {
      f32x4 acc[4][2];
#pragma unroll
      for (int m = 0; m < 4; ++m)
#pragma unroll
        for (int n = 0; n < 2; ++n) acc[m][n] = f32x4{0.f, 0.f, 0.f, 0.f};
#pragma unroll
      for (int ks = 0; ks < 4; ++ks) {
        bf16x8 bf[2], af[4];
#pragma unroll
        for (int n = 0; n < 2; ++n) bf[n] = *(const bf16x8*)((const u16*)(P.ws + G2T_OFF) + (size_t)(c0 + nh * 32 + 8 * (fr >> 2) + 4 * n + (fr & 3)) * 128 + ks * 32 + fq * 8);
#pragma unroll
        for (int m = 0; m < 4; ++m) af[m] = *(const bf16x8*)(As + (m * 16 + fr) * 136 + ks * 32 + fq * 8);
#pragma unroll
        for (int m = 0; m < 4; ++m)
#pragma unroll
          for (int n = 0; n < 2; ++n) acc[m][n] = MFMA16(bf[n], af[m], acc[m][n]);
        __builtin_amdgcn_sched_barrier(0);
      }
#pragma unroll
      for (int m = 0; m < 4; ++m) *(uint4*)(Gs + (m * 16 + fr) * 520 + c0 + nh * 32 + 8 * fq) = pack8(acc[m][0], acc[m][1]);
    }
#pragma unroll 1
    for (int m = 0; m < 4; ++m)
      final_rows(PT, ZR, AA, Y, RW, Gs + (m * 16 + fr) * 520 + c0 + 8 * fq, t0 + m * 16 + fr, c0, fq, fr);
    __syncthreads();
  }
}

DI void p5_merge(const Params& P, char* smem) {
  const u16* WB = (const u16*)P.ws;
  EpiMergeCat E{(u16*)(P.ws + MERGED_OFF), (const u16*)(P.ws + GATES_OFF)};
  run_gemm_cat(smem, (const u16*)(P.ws + ATTN_OFF), WB + WT_UA, (const u16*)(P.ws + RW_OFF), WB + WT_UR, 1024, 512, E);
}
DI void p6_outproj(const Params& P, char* smem) {
  EpiResidP E{P.out, P.x};
  run_gemm(smem, (const u16*)(P.ws + MERGED_OFF), (const u16*)P.ws + WT_OUT, 1024, 1024, E);
}
DI void p8_ff1(const Params& P, char* smem) {
  EpiRelu2P E{(u16*)(P.ws + HID_OFF)};
  run_gemm(smem, (const u16*)(P.ws + HF_OFF), (const u16*)P.ws + WT_FF1, 4096, 1024, E);
}
DI void p9_ff2(const Params& P, char* smem) {
  EpiResidP E{P.out, P.out};
  run_gemm(smem, (const u16*)(P.ws + HID_OFF), (const u16*)P.ws + WT_FF2, 1024, 4096, E);
}
DI void p10_cvt_p(const Params& P) {
  u16* PB = (u16*)(P.ws + PB_OFF);
  const float4* p4 = (const float4*)P.p;
  for (int e = blockIdx.x * NTHR + threadIdx.x; e < T * 256 / 4; e += gridDim.x * NTHR) {
    float4 v = p4[e]; uint2 o; o.x = pack2(v.x, v.y); o.y = pack2(v.z, v.w);
    *(uint2*)(PB + (size_t)e * 4) = o;
  }
}
DI void p11_ple(const Params& P, char* smem) {
  const u16* WB = (const u16*)P.ws;
  EpiStoreBfP E1{(u16*)(P.ws + PE_OFF)};
  run_gemm(smem, (const u16*)(P.ws + PB_OFF), WB + WT_PL, 1024, 256, E1);
  EpiPle2P E2{P.out, (const u16*)(P.ws + PE_OFF)};
  run_gemm(smem, (const u16*)(P.ws + HP_OFF), WB + WT_PG, 1024, 1024, E2);
}

constexpr size_t BAR_OFF = 33292288;
__global__ void __launch_bounds__(NTHR) mega(Params P, int never) {
  extern __shared__ __attribute__((aligned(16))) char smem[];
  volatile LAS unsigned* st = (volatile LAS unsigned*)(smem + 131072);
  if (threadIdx.x < 4) st[threadIdx.x] = 0u;
  __syncthreads();
  XcdBarrier xb = xcd_barrier_post((unsigned*)(P.ws + BAR_OFF), st);
  if (never) cg::this_grid().sync();
#define SYNC() xcd_barrier(xb)
  p0_prep(P, smem); rmsnorm_rows(P.x, P.norm_mix, (u16*)P.out); SYNC();
  p1_proj(P, smem); SYNC();
  p2_attn(P, smem); p2_prep(P, smem); SYNC();
  p3_scan(P, smem); SYNC();
  p4_final(P, smem); SYNC();
  p5_merge(P, smem); SYNC();
  p6_outproj(P, smem); SYNC();
  rmsnorm_rows(P.out, P.norm_ffn, (u16*)(P.ws + HF_OFF)); SYNC();
  p8_ff1(P, smem); SYNC();
  p9_ff2(P, smem); SYNC();
  rmsnorm_rows(P.out, P.norm_ple, (u16*)(P.ws + HP_OFF)); p10_cvt_p(P); SYNC();
  p11_ple(P, smem);
#undef SYNC
}

extern "C" void kernel_launch(void* const* d_in, const int* in_sizes, int n_in, void* d_out, int out_size, void* d_ws,
                              size_t ws_size, hipStream_t stream) {
  static int grid = 0;
  if (grid == 0) {
    int dev = 0, cus = 0, per_cu = 0;
    (void)hipGetDevice(&dev);
    (void)hipDeviceGetAttribute(&cus, hipDeviceAttributeMultiprocessorCount, dev);
    (void)hipFuncSetAttribute((const void*)mega, hipFuncAttributeMaxDynamicSharedMemorySize, LDS_BYTES);
    (void)hipOccupancyMaxActiveBlocksPerMultiprocessor(&per_cu, (const void*)mega, NTHR, LDS_BYTES);
    if (per_cu < 1) per_cu = 1;
    grid = cus * per_cu;
    if (ws_size < 268435456ull) fprintf(stderr, "kernel_launch: workspace too small: %zu\n", ws_size);
    fprintf(stderr, "kernel_launch: grid %d (cus %d x %d)\n", grid, cus, per_cu);
  }
  Params P{};
  const float** pp = (const float**)&P;
  for (int i = 0; i < 27; ++i) pp[i] = (const float*)d_in[i];
  P.out = (float*)d_out; P.ws = (char*)d_ws;
  (void)hipMemsetAsync((char*)d_ws + BAR_OFF, 0, XCD_BAR_WORDS * 4, stream);
  int never = 0;
  void* args[] = {&P, &never};
  hipError_t e = hipLaunchCooperativeKernel((const void*)mega, dim3(grid), dim3(NTHR), args, LDS_BYTES, stream);
  if (e != hipSuccess) fprintf(stderr, "cooperative launch failed: %s\n", hipGetErrorString(e));
}
```
